# Optimizing an MI355X kernel written in HIP

```python
import math
import jax, jax.numpy as jnp
from jax import lax
import numpy as np

D_MODEL = 2048
BATCH = 4
SEQ = 2048
DEPTH = 1

MEM_LEN = 256
DIFF_HEADS = 8
DIFF_HEAD_DIM = 128
DIFF_QK_WIDTH = DIFF_HEADS * 2 * DIFF_HEAD_DIM
DIFF_V_WIDTH = DIFF_HEADS * 2 * DIFF_HEAD_DIM
Q_BLOCK = 128
CONV_WIDTH = D_MODEL
CONV_K = 3
MIX_IN_SPLITS = (DIFF_QK_WIDTH, DIFF_QK_WIDTH, DIFF_V_WIDTH,
                 CONV_WIDTH, CONV_WIDTH, CONV_WIDTH,
                 D_MODEL, D_MODEL)
MIX_IN_WIDTH = sum(MIX_IN_SPLITS)
MIX_IN_OFFSETS = tuple(int(o) for o in np.cumsum(MIX_IN_SPLITS)[:-1])
N_BRANCHES = 2
XATTN_HEADS = 4
XATTN_HEAD_DIM = 128
XATTN_WIDTH = XATTN_HEADS * XATTN_HEAD_DIM
D_FF = 128 * ((8 * D_MODEL // 3 + 127) // 128)
NORM_EPS = 1e-6
SUBLN_EPS = 1e-5

kernel_name = 'hybrid_diffattn_shortconv_macaron'


def rms_norm(x, g, eps=NORM_EPS):
    xf = x.astype(jnp.float32)
    y = xf * lax.rsqrt(jnp.mean(xf * xf, axis=-1, keepdims=True) + eps)
    return (y * g.astype(jnp.float32)).astype(x.dtype)


def swiglu(h, w_gate, w_up, w_down):
    return (jax.nn.silu(h @ w_gate) * (h @ w_up)) @ w_down


def diff_lambda(lq1, lk1, lq2, lk2, lam_init):
    f = jnp.float32
    return (jnp.exp(jnp.dot(lq1.astype(f), lk1.astype(f)))
            - jnp.exp(jnp.dot(lq2.astype(f), lk2.astype(f))) + lam_init)


def diff_attention(q, k, v, lam):
    s = q.shape[1]
    scale = q.shape[-1] ** -0.5
    qh = jnp.transpose(q, (0, 2, 3, 1, 4)) * scale
    kh = jnp.transpose(k, (0, 2, 3, 1, 4))
    vh = jnp.transpose(v, (0, 2, 1, 3))
    outs = []
    for i in range(s // Q_BLOCK):
        q0, q1 = i * Q_BLOCK, (i + 1) * Q_BLOCK
        qb = qh[:, :, :, q0:q1]
        kb = kh[:, :, :, :q1]
        vb = vh[:, :, :q1]
        sc = jnp.einsum('bhcqd,bhckd->bhcqk', qb, kb).astype(jnp.float32)
        causal = jnp.arange(q1)[None, :] <= jnp.arange(q0, q1)[:, None]
        sc = jnp.where(causal, sc, -jnp.inf)
        p = jax.nn.softmax(sc, axis=-1)
        a = p[:, :, 0] - lam * p[:, :, 1]
        outs.append(jnp.einsum('bhqk,bhkd->bhqd', a.astype(v.dtype), vb))
    o = jnp.concatenate(outs, axis=2)
    return jnp.transpose(o, (0, 2, 1, 3))


def causal_depthwise_conv(u, w):
    c = u.shape[-1]
    return lax.conv_general_dilated(
        u, w[:, None, :], window_strides=(1,), padding=((CONV_K - 1, 0),),
        dimension_numbers=('NWC', 'WIO', 'NWC'), feature_group_count=c)


def cross_attention(h, m, w_q, w_kv, w_o):
    b, s, _ = h.shape
    n_mem = m.shape[1]
    q = (h @ w_q).reshape(b, s, XATTN_HEADS, XATTN_HEAD_DIM)
    kv = (m @ w_kv).reshape(b, n_mem, 2, XATTN_HEADS, XATTN_HEAD_DIM)
    k, v = kv[:, :, 0], kv[:, :, 1]
    sc = jnp.einsum('bshd,bmhd->bhsm', q, k).astype(jnp.float32) * (XATTN_HEAD_DIM ** -0.5)
    p = jax.nn.softmax(sc, axis=-1)
    o = jnp.einsum('bhsm,bmhd->bshd', p.astype(v.dtype), v).reshape(b, s, XATTN_WIDTH)
    return o @ w_o


def setup_inputs(seed: int = 0) -> dict:
    key = jax.random.key(seed)
    ks = jax.random.split(key, 32)
    f = jnp.float32

    def w(k, shape, fan_in):
        return jax.random.normal(k, shape, f) * (fan_in ** -0.5)

    def g(k, shape):
        return 1.0 + 0.01 * jax.random.normal(k, shape, f)

    L, D = DEPTH, D_MODEL
    return {
        'x': jax.random.normal(ks[0], (BATCH, SEQ, D), f),
        'mem': jax.random.normal(ks[1], (BATCH, MEM_LEN, D), f),
        'ffn1_norm': g(ks[2], (L, D)),
        'ffn1_w_gate': w(ks[3], (L, D, D_FF), D),
        'ffn1_w_up': w(ks[4], (L, D, D_FF), D),
        'ffn1_w_down': w(ks[5], (L, D_FF, D), D_FF),
        'mix_norm': g(ks[6], (L, D)),
        'w_mix_in': w(ks[7], (L, D, MIX_IN_WIDTH), D),
        'b_gates': 0.1 * jax.random.normal(ks[8], (L, N_BRANCHES, D), f),
        'lambda_q1': 0.1 * jax.random.normal(ks[9], (L, DIFF_HEAD_DIM), f),
        'lambda_k1': 0.1 * jax.random.normal(ks[10], (L, DIFF_HEAD_DIM), f),
        'lambda_q2': 0.1 * jax.random.normal(ks[11], (L, DIFF_HEAD_DIM), f),
        'lambda_k2': 0.1 * jax.random.normal(ks[12], (L, DIFF_HEAD_DIM), f),
        'diff_subln': g(ks[13], (L, 2 * DIFF_HEAD_DIM)),
        'w_attn_out': w(ks[14], (L, DIFF_V_WIDTH, D), DIFF_V_WIDTH),
        'conv_w': w(ks[15], (L, CONV_K, CONV_WIDTH), CONV_K),
        'w_conv_out': w(ks[16], (L, CONV_WIDTH, D), CONV_WIDTH),
        'w_mix_out': w(ks[17], (L, D, D), D),
        'xattn_norm': g(ks[18], (L, D)),
        'mem_norm': g(ks[19], (L, D)),
        'w_xq': w(ks[20], (L, D, XATTN_WIDTH), D),
        'w_xkv': w(ks[21], (L, D, 2 * XATTN_WIDTH), D),
        'w_xo': w(ks[22], (L, XATTN_WIDTH, D), XATTN_WIDTH),
        'ffn2_norm': g(ks[23], (L, D)),
        'ffn2_w_gate': w(ks[24], (L, D, D_FF), D),
        'ffn2_w_up': w(ks[25], (L, D, D_FF), D),
        'ffn2_w_down': w(ks[26], (L, D_FF, D), D_FF),
        'final_norm': g(ks[27], (D,)),
    }


def reference(x, mem, ffn1_norm, ffn1_w_gate, ffn1_w_up, ffn1_w_down,
              mix_norm, w_mix_in, b_gates, lambda_q1, lambda_k1, lambda_q2, lambda_k2,
              diff_subln, w_attn_out, conv_w, w_conv_out, w_mix_out,
              xattn_norm, mem_norm, w_xq, w_xkv, w_xo,
              ffn2_norm, ffn2_w_gate, ffn2_w_up, ffn2_w_down, final_norm):
    b, s, _ = x.shape
    for l in range(DEPTH):
        x = x + 0.5 * swiglu(rms_norm(x, ffn1_norm[l]), ffn1_w_gate[l], ffn1_w_up[l], ffn1_w_down[l])

        h = rms_norm(x, mix_norm[l])
        z = h @ w_mix_in[l]
        q, k, v, gate_b, gate_c, u, ga_pre, gc_pre = jnp.split(z, MIX_IN_OFFSETS, axis=-1)

        lam_init = 0.8 - 0.6 * math.exp(-0.3 * l)
        lam = diff_lambda(lambda_q1[l], lambda_k1[l], lambda_q2[l], lambda_k2[l], lam_init)
        ya = diff_attention(q.reshape(b, s, DIFF_HEADS, 2, DIFF_HEAD_DIM),
                            k.reshape(b, s, DIFF_HEADS, 2, DIFF_HEAD_DIM),
                            v.reshape(b, s, DIFF_HEADS, 2 * DIFF_HEAD_DIM), lam)
        ya = rms_norm(ya, diff_subln[l], SUBLN_EPS) * (1.0 - lam_init)
        ya = ya.reshape(b, s, DIFF_V_WIDTH) @ w_attn_out[l]

        yc = (gate_b * causal_depthwise_conv(gate_c * u, conv_w[l])) @ w_conv_out[l]

        ga = jax.nn.sigmoid(ga_pre + b_gates[l, 0])
        gc = jax.nn.sigmoid(gc_pre + b_gates[l, 1])
        x = x + (ga * ya + gc * yc) @ w_mix_out[l]

        x = x + cross_attention(rms_norm(x, xattn_norm[l]), rms_norm(mem, mem_norm[l]),
                                w_xq[l], w_xkv[l], w_xo[l])

        x = x + 0.5 * swiglu(rms_norm(x, ffn2_norm[l]), ffn2_w_gate[l], ffn2_w_up[l], ffn2_w_down[l])
    return rms_norm(x, final_norm)
```

```cpp
#include <hip/hip_runtime.h>
#include <hip/hip_cooperative_groups.h>
#include <hip/hip_bf16.h>
#include <cstdio>
#include <cstdint>
namespace cg = cooperative_groups;
namespace pg8 {
#define PG8_LAS __attribute__((address_space(3)))
typedef unsigned short bf16_t;
typedef short bf16x8 __attribute__((ext_vector_type(8)));
typedef float f32x4 __attribute__((ext_vector_type(4)));
typedef unsigned u32x4 __attribute__((ext_vector_type(4)));
constexpr int BM = 256, BK = 64, HALF = 128, HTB = HALF * BK * 2  , STAGE_BYTES = 8 * HTB, NXCD = 8, WGM = 8;

__host__ __device__ __forceinline__ int lds_byte(int r, int c) { const int st = (r >> 4) * 2 + (c >> 5), rr = r & 15, cc = c & 31, ob = rr * 64 + cc * 2; return st * 1024 + (ob ^ (((ob >> 9) & 1) << 5)); }
__host__ __device__ __forceinline__ void stage_rc(int b, int& R, int& C) { const int st = b / 1024, sb = b % 1024, swz = sb ^ (((sb >> 9) & 1) << 5); R = (st >> 1) * 16 + swz / 64; C = (st & 1) * 32 + (swz % 64) / 2; }
__host__ __device__ __forceinline__ int perm32(int rho) { const int n = rho >> 4, i = rho & 15; return 8 * (i >> 2) + 4 * n + (i & 3); }

struct Unit { int pm, pn; };
struct Gemm { const bf16_t* A; const bf16_t* Bt; int M, N, K, ablk, bblk; };
__host__ __device__ __forceinline__ size_t blk(int row, int col, int K) { return (size_t)(row >> 8) * (size_t)(256 * K) + (size_t)((col >> 6) * 16384 + (row & 255) * 64 + (col & 63)); }

struct StaticOrder {
    int nM, nN, nwg, G, c;
    __host__ __device__ void init(int M, int N, int G_, int c_) { nM = M / BM; nN = N / BM; nwg = nM * nN; G = G_; c = c_; }
    __host__ __device__ bool next(int i, Unit& u) const {
        const long L = (long)i * G + c; if (L >= nwg) return false;
        int wgid = (int)L; { const int q = nwg / NXCD, r = nwg % NXCD, xcd = wgid % NXCD, off = wgid / NXCD; wgid = (xcd < r ? xcd * (q + 1) : r * (q + 1) + (xcd - r) * q) + off; }
        const int nig = WGM * nN, gid = wgid / nig, fm = gid * WGM, gsz = (nM - fm) < WGM ? (nM - fm) : WGM;
        u.pm = fm + ((wgid % nig) % gsz); u.pn = (wgid % nig) / gsz; return true;
    }
    __device__ __forceinline__ void a_ready(const Unit&) const {}
    __device__ __forceinline__ void done(const Unit&) const {}
};

typedef float f32x2_cv __attribute__((ext_vector_type(2))); typedef __bf16 bf16x2_cv __attribute__((ext_vector_type(2)));
__device__ __forceinline__ unsigned cvt_pk_bf16(float lo, float hi) { f32x2_cv v = {lo, hi}; bf16x2_cv b = __builtin_convertvector(v, bf16x2_cv); return __builtin_bit_cast(unsigned, b); }
typedef float f32x2 __attribute__((ext_vector_type(2)));
__device__ __forceinline__ f32x2 gelu_pk(f32x2 v) {
    const f32x2 av = __builtin_elementwise_abs(v), d = av * 0.2316418882f + 1.0f;
    f32x2 t; t.x = __builtin_amdgcn_rcpf(d.x); t.y = __builtin_amdgcn_rcpf(d.y);
    f32x2 q = t * 0.5307027145f + (-0.7265760135f); q = q * t + 0.7107068705f; q = q * t + (-0.142248368f); q = q * t + 0.127414796f; q = q * t;
    const f32x2 s = (v * v) * (-0.72134752044f);
    f32x2 e; e.x = __builtin_amdgcn_exp2f(s.x); e.y = __builtin_amdgcn_exp2f(s.y);
    const f32x2 m = v * (q * e), r = v - m;
    f32x2 o; o.x = v.x < 0.f ? m.x : r.x; o.y = v.y < 0.f ? m.y : r.y; return o;
}

template <int ACT  > struct EpiBf16 {
    static constexpr bool PERM = true, AFTER_DRAIN = false; static_assert(ACT == 0 || ACT == 1, "EpiBf16: ACT is 0 (none) or 1 (gelu_pk)");
    bf16_t* O; int ldc; const float* bias; int split_cols; size_t split_stride; float scale0;
    __device__ __forceinline__ void operator()(const f32x4 (&acc)[2][2][4][2], const Unit& u, int wr, int wc, int fr, int fq) const {
        const int row0 = u.pm * BM + wr * 64 + fr; int colt = u.pn * BM; bf16_t* base = O;
        float sc = 1.f; if (split_cols) { const int t = colt / split_cols; base += (size_t)t * split_stride; colt -= t * split_cols; if (t == 0) sc = scale0; }
        const int col0 = colt + wc * 32 + 8 * fq, bcol0 = u.pn * BM + wc * 32 + 8 * fq;
        f32x4 bv[2][2];
#pragma unroll
        for (int bj = 0; bj < 2; ++bj)
#pragma unroll
            for (int n = 0; n < 2; ++n) bv[bj][n] = bias ? *(const f32x4*)(bias + bcol0 + bj * HALF + 4 * n) : (f32x4){0.f, 0.f, 0.f, 0.f};
#pragma unroll
        for (int ai = 0; ai < 2; ++ai)
#pragma unroll
            for (int m = 0; m < 4; ++m) { bf16_t* rowp = base + (size_t)(row0 + ai * HALF + m * 16) * ldc + col0;
#pragma unroll
                for (int bj = 0; bj < 2; ++bj) { f32x4 v0 = acc[ai][bj][m][0] + bv[bj][0], v1 = acc[ai][bj][m][1] + bv[bj][1];
                    if (ACT == 1) { f32x2 a = gelu_pk((f32x2){v0[0], v0[1]}), b = gelu_pk((f32x2){v0[2], v0[3]}), c = gelu_pk((f32x2){v1[0], v1[1]}), d = gelu_pk((f32x2){v1[2], v1[3]});
                        v0 = (f32x4){a.x, a.y, b.x, b.y}; v1 = (f32x4){c.x, c.y, d.x, d.y}; }
                    v0 = v0 * sc; v1 = v1 * sc; u32x4 w; w.x = cvt_pk_bf16(v0[0], v0[1]); w.y = cvt_pk_bf16(v0[2], v0[3]); w.z = cvt_pk_bf16(v1[0], v1[1]); w.w = cvt_pk_bf16(v1[2], v1[3]);
                    *(u32x4*)(rowp + bj * HALF) = w; } }
    }
};

__device__ __forceinline__ float bf2f(unsigned short b) { return __uint_as_float(((unsigned)b) << 16); }
__device__ __forceinline__ float sigmoidf_(float v) { return __builtin_amdgcn_rcpf(1.0f + __builtin_amdgcn_exp2f(-1.4426950408889634f * v)); }
__device__ __forceinline__ f32x4 lo4(u32x4 w) { return (f32x4){__uint_as_float(w.x << 16), __uint_as_float(w.x & 0xffff0000u), __uint_as_float(w.y << 16), __uint_as_float(w.y & 0xffff0000u)}; }
__device__ __forceinline__ f32x4 hi4(u32x4 w) { return (f32x4){__uint_as_float(w.z << 16), __uint_as_float(w.z & 0xffff0000u), __uint_as_float(w.w << 16), __uint_as_float(w.w & 0xffff0000u)}; }
__device__ __forceinline__ u32x4 pack8f(f32x4 a, f32x4 b) { u32x4 w; w.x = cvt_pk_bf16(a[0], a[1]); w.y = cvt_pk_bf16(a[2], a[3]); w.z = cvt_pk_bf16(b[0], b[1]); w.w = cvt_pk_bf16(b[2], b[3]); return w; }

__device__ __forceinline__ float row_rscale(const float* SS, int row, int fq) {
    const f32x4 a = *(const f32x4*)(SS + (size_t)row * 32 + fq * 8), b = *(const f32x4*)(SS + (size_t)row * 32 + fq * 8 + 4);
    float s = ((a[0] + a[1]) + (a[2] + a[3])) + ((b[0] + b[1]) + (b[2] + b[3]));
    s += __shfl_xor(s, 16); s += __shfl_xor(s, 32);
    return 1.0f / sqrtf(s * (1.f / 2048.f) + 1e-6f);
}
struct EpiSwiglu {
    static constexpr bool PERM = true, AFTER_DRAIN = false;
    bf16_t* O; int ldc; const float* SS;
    __device__ __forceinline__ void operator()(const f32x4 (&acc)[2][2][4][2], const Unit& u, int wr, int wc, int fr, int fq) const {
        const int row0 = u.pm * BM + wr * 64 + fr, col0 = u.pn * HALF + wc * 32 + 8 * fq;
        float rsa[2][4];
#pragma unroll
        for (int ai = 0; ai < 2; ++ai)
#pragma unroll
            for (int m = 0; m < 4; ++m) rsa[ai][m] = SS ? row_rscale(SS, row0 + ai * HALF + m * 16, fq) : 1.f;
#pragma unroll
        for (int ai = 0; ai < 2; ++ai)
#pragma unroll
            for (int m = 0; m < 4; ++m) { bf16_t* rowp = O + blk(row0 + ai * HALF + m * 16, col0, ldc);
                const float rs = rsa[ai][m];
                f32x4 v[2];
#pragma unroll
                for (int n = 0; n < 2; ++n) { const f32x4 g = acc[ai][0][m][n] * rs, up = acc[ai][1][m][n] * rs;
#pragma unroll
                    for (int j = 0; j < 4; ++j) v[n][j] = g[j] * sigmoidf_(g[j]) * up[j]; }
                *(u32x4*)rowp = pack8f(v[0], v[1]); }
    }
};
struct EpiResid {
    static constexpr bool PERM = true, AFTER_DRAIN = false;
    const float* base; float* out; int ldc; float alpha;
    __device__ __forceinline__ void operator()(const f32x4 (&acc)[2][2][4][2], const Unit& u, int wr, int wc, int fr, int fq) const {
        const int row0 = u.pm * BM + wr * 64 + fr, col0 = u.pn * BM + wc * 32 + 8 * fq;
#pragma unroll
        for (int ai = 0; ai < 2; ++ai) { f32x4 b[4][2][2];
#pragma unroll
            for (int m = 0; m < 4; ++m) { const size_t off = (size_t)(row0 + ai * HALF + m * 16) * ldc + col0;
#pragma unroll
                for (int bj = 0; bj < 2; ++bj) { b[m][bj][0] = *(const f32x4*)(base + off + bj * HALF); b[m][bj][1] = *(const f32x4*)(base + off + bj * HALF + 4); } }
#pragma unroll
            for (int m = 0; m < 4; ++m) { const size_t off = (size_t)(row0 + ai * HALF + m * 16) * ldc + col0;
#pragma unroll
                for (int bj = 0; bj < 2; ++bj) { *(f32x4*)(out + off + bj * HALF) = b[m][bj][0] + alpha * acc[ai][bj][m][0]; *(f32x4*)(out + off + bj * HALF + 4) = b[m][bj][1] + alpha * acc[ai][bj][m][1]; } } }
    }
};
struct EpiResidN {
    static constexpr bool PERM = true, AFTER_DRAIN = false;
    const float* base; float* out; bf16_t* XB; float* SS; float alpha;
    __device__ __forceinline__ void operator()(const f32x4 (&acc)[2][2][4][2], const Unit& u, int wr, int wc, int fr, int fq) const {
        const int row0 = u.pm * BM + wr * 64 + fr, col0 = u.pn * BM + wc * 32 + 8 * fq;
#pragma unroll
        for (int ai = 0; ai < 2; ++ai) { f32x4 b[4][2][2];
#pragma unroll
            for (int m = 0; m < 4; ++m) { const size_t off = (size_t)(row0 + ai * HALF + m * 16) * 2048 + col0;
#pragma unroll
                for (int bj = 0; bj < 2; ++bj) { b[m][bj][0] = *(const f32x4*)(base + off + bj * HALF); b[m][bj][1] = *(const f32x4*)(base + off + bj * HALF + 4); } }
#pragma unroll
            for (int m = 0; m < 4; ++m) { const int row = row0 + ai * HALF + m * 16; const size_t off = (size_t)row * 2048 + col0; float ssq = 0.f;
#pragma unroll
                for (int bj = 0; bj < 2; ++bj) { const f32x4 o0 = b[m][bj][0] + alpha * acc[ai][bj][m][0], o1 = b[m][bj][1] + alpha * acc[ai][bj][m][1];
                    *(f32x4*)(out + off + bj * HALF) = o0; *(f32x4*)(out + off + bj * HALF + 4) = o1;
                    *(u32x4*)(XB + off + bj * HALF) = pack8f(o0, o1);
                    ssq += ((o0[0] * o0[0] + o0[1] * o0[1]) + (o0[2] * o0[2] + o0[3] * o0[3])) + ((o1[0] * o1[0] + o1[1] * o1[1]) + (o1[2] * o1[2] + o1[3] * o1[3])); }
                ssq += __shfl_xor(ssq, 16); ssq += __shfl_xor(ssq, 32);
                if (fq == 0) SS[(size_t)row * 32 + u.pn * 4 + wc] = ssq; } }
    }
};
template <bool BASE_F32> struct EpiResidB {
    static constexpr bool PERM = true, AFTER_DRAIN = false;
    const void* base; bf16_t* XB; float* SS; float alpha;
    __device__ __forceinline__ void operator()(const f32x4 (&acc)[2][2][4][2], const Unit& u, int wr, int wc, int fr, int fq) const {
        const int row0 = u.pm * BM + wr * 64 + fr, col0 = u.pn * BM + wc * 32 + 8 * fq;
#pragma unroll
        for (int ai = 0; ai < 2; ++ai) { f32x4 b[4][2][2];
#pragma unroll
            for (int m = 0; m < 4; ++m) { const size_t off = (size_t)(row0 + ai * HALF + m * 16) * 2048 + col0;
#pragma unroll
                for (int bj = 0; bj < 2; ++bj) {
                    if constexpr (BASE_F32) { b[m][bj][0] = __builtin_nontemporal_load((const f32x4*)((const float*)base + off + bj * HALF)); b[m][bj][1] = __builtin_nontemporal_load((const f32x4*)((const float*)base + off + bj * HALF + 4)); }
                    else { const u32x4 w = __builtin_nontemporal_load((const u32x4*)((const bf16_t*)base + blk(row0 + ai * HALF + m * 16, col0 + bj * HALF, 2048))); b[m][bj][0] = lo4(w); b[m][bj][1] = hi4(w); } } }
#pragma unroll
            for (int m = 0; m < 4; ++m) { const int row = row0 + ai * HALF + m * 16; const size_t off = (size_t)row * 2048 + col0; float ssq = 0.f;
#pragma unroll
                for (int bj = 0; bj < 2; ++bj) { const f32x4 o0 = b[m][bj][0] + alpha * acc[ai][bj][m][0], o1 = b[m][bj][1] + alpha * acc[ai][bj][m][1];
                    *(u32x4*)(XB + blk(row, col0 + bj * HALF, 2048)) = pack8f(o0, o1);
                    ssq += ((o0[0] * o0[0] + o0[1] * o0[1]) + (o0[2] * o0[2] + o0[3] * o0[3])) + ((o1[0] * o1[0] + o1[1] * o1[1]) + (o1[2] * o1[2] + o1[3] * o1[3])); }
                ssq += __shfl_xor(ssq, 16); ssq += __shfl_xor(ssq, 32);
                if (fq == 0) SS[(size_t)row * 32 + u.pn * 4 + wc] = ssq; } }
    }
};
struct EpiResidFromB {
    static constexpr bool PERM = true, AFTER_DRAIN = false;
    const bf16_t* XB; float* out; float alpha;
    __device__ __forceinline__ void operator()(const f32x4 (&acc)[2][2][4][2], const Unit& u, int wr, int wc, int fr, int fq) const {
        const int row0 = u.pm * BM + wr * 64 + fr, col0 = u.pn * BM + wc * 32 + 8 * fq;
#pragma unroll
        for (int ai = 0; ai < 2; ++ai)
#pragma unroll
            for (int m = 0; m < 4; ++m) { const size_t off = (size_t)(row0 + ai * HALF + m * 16) * 2048 + col0;
#pragma unroll
                for (int bj = 0; bj < 2; ++bj) { const u32x4 w = *(const u32x4*)(XB + blk(row0 + ai * HALF + m * 16, col0 + bj * HALF, 2048));
                    *(f32x4*)(out + off + bj * HALF) = lo4(w) + alpha * acc[ai][bj][m][0]; *(f32x4*)(out + off + bj * HALF + 4) = hi4(w) + alpha * acc[ai][bj][m][1]; } }
    }
};
struct EpiBf16RS {
    static constexpr bool PERM = true, AFTER_DRAIN = false;
    bf16_t* O; int ldc; const float* SS;
    __device__ __forceinline__ void operator()(const f32x4 (&acc)[2][2][4][2], const Unit& u, int wr, int wc, int fr, int fq) const {
        const int row0 = u.pm * BM + wr * 64 + fr, col0 = u.pn * BM + wc * 32 + 8 * fq;
        float rsa[2][4];
#pragma unroll
        for (int ai = 0; ai < 2; ++ai)
#pragma unroll
            for (int m = 0; m < 4; ++m) rsa[ai][m] = row_rscale(SS, row0 + ai * HALF + m * 16, fq);
#pragma unroll
        for (int ai = 0; ai < 2; ++ai)
#pragma unroll
            for (int m = 0; m < 4; ++m) { const int row = row0 + ai * HALF + m * 16; const float rs = rsa[ai][m];
#pragma unroll
                for (int bj = 0; bj < 2; ++bj) *(u32x4*)(O + (size_t)row * ldc + col0 + bj * HALF) = pack8f(acc[ai][bj][m][0] * rs, acc[ai][bj][m][1] * rs); }
    }
};
struct EpiMixIn {
    static constexpr bool PERM = true, AFTER_DRAIN = false;
    bf16_t* base; const float* bg; const float* SS;
    __device__ __forceinline__ void operator()(const f32x4 (&acc)[2][2][4][2], const Unit& u, int wr, int wc, int fr, int fq) const {
        const int seg = u.pn >> 3, row0 = u.pm * BM + wr * 64 + fr; constexpr size_t RS = (size_t)8192 * 2048;
        bf16_t* CU = base + 4 * RS;
        float rs[2][4];
#pragma unroll
        for (int ai = 0; ai < 2; ++ai)
#pragma unroll
            for (int m = 0; m < 4; ++m) rs[ai][m] = row_rscale(SS, row0 + ai * HALF + m * 16, fq);
        if (seg == 4 || seg == 5) {
            const int col0 = (u.pn - 32) * HALF + wc * 32 + 8 * fq;
#pragma unroll
            for (int ai = 0; ai < 2; ++ai)
#pragma unroll
                for (int m = 0; m < 4; ++m) *(u32x4*)(CU + (size_t)(row0 + ai * HALF + m * 16) * 2048 + col0) = pack8f(acc[ai][0][m][0] * acc[ai][1][m][0] * (rs[ai][m] * rs[ai][m]), acc[ai][0][m][1] * acc[ai][1][m][1] * (rs[ai][m] * rs[ai][m]));
        } else if (seg >= 6) {
            bf16_t* dst = base + (size_t)(seg - 1) * RS; const int col0 = (u.pn & 7) * BM + wc * 32 + 8 * fq; const float* bb = bg + (seg - 6) * 2048 + col0;
#pragma unroll
            for (int bj = 0; bj < 2; ++bj) { const f32x4 b0 = *(const f32x4*)(bb + bj * HALF), b1 = *(const f32x4*)(bb + bj * HALF + 4);
#pragma unroll
                for (int ai = 0; ai < 2; ++ai)
#pragma unroll
                    for (int m = 0; m < 4; ++m) { f32x4 v0 = acc[ai][bj][m][0] * rs[ai][m] + b0, v1 = acc[ai][bj][m][1] * rs[ai][m] + b1;
#pragma unroll
                        for (int j = 0; j < 4; ++j) { v0[j] = sigmoidf_(v0[j]); v1[j] = sigmoidf_(v1[j]); }
                        *(u32x4*)(dst + (size_t)(row0 + ai * HALF + m * 16) * 2048 + col0 + bj * HALF) = pack8f(v0, v1); } }
        } else {
            bf16_t* dst = base + (size_t)seg * RS; const int col0 = (u.pn & 7) * BM + wc * 32 + 8 * fq;
#pragma unroll
            for (int ai = 0; ai < 2; ++ai)
#pragma unroll
                for (int m = 0; m < 4; ++m)
#pragma unroll
                    for (int bj = 0; bj < 2; ++bj) *(u32x4*)(dst + (size_t)(row0 + ai * HALF + m * 16) * 2048 + col0 + bj * HALF) = pack8f(acc[ai][bj][m][0] * rs[ai][m], acc[ai][bj][m][1] * rs[ai][m]);
        }
    }
};
struct EpiGateT {
    static constexpr bool PERM = true, AFTER_DRAIN = false;
    const bf16_t* G; bf16_t* T;
    __device__ __forceinline__ void operator()(const f32x4 (&acc)[2][2][4][2], const Unit& u, int wr, int wc, int fr, int fq) const {
        const int row0 = u.pm * BM + wr * 64 + fr, col0 = u.pn * BM + wc * 32 + 8 * fq;
#pragma unroll
        for (int ai = 0; ai < 2; ++ai) { u32x4 g[4][2];
#pragma unroll
            for (int m = 0; m < 4; ++m)
#pragma unroll
                for (int bj = 0; bj < 2; ++bj) g[m][bj] = __builtin_nontemporal_load((const u32x4*)(G + (size_t)(row0 + ai * HALF + m * 16) * 2048 + col0 + bj * HALF));
#pragma unroll
            for (int m = 0; m < 4; ++m)
#pragma unroll
                for (int bj = 0; bj < 2; ++bj) *(u32x4*)(T + (size_t)(row0 + ai * HALF + m * 16) * 2048 + col0 + bj * HALF) = pack8f(lo4(g[m][bj]) * acc[ai][bj][m][0], hi4(g[m][bj]) * acc[ai][bj][m][1]); }
    }
};
struct EpiGateMrg {
    static constexpr bool PERM = true, AFTER_DRAIN = false;
    const bf16_t* G; const bf16_t* T; bf16_t* O;
    __device__ __forceinline__ void operator()(const f32x4 (&acc)[2][2][4][2], const Unit& u, int wr, int wc, int fr, int fq) const {
        const int row0 = u.pm * BM + wr * 64 + fr, col0 = u.pn * BM + wc * 32 + 8 * fq;
#pragma unroll
        for (int ai = 0; ai < 2; ++ai) { u32x4 g[4][2], t[4][2];
#pragma unroll
            for (int m = 0; m < 4; ++m)
#pragma unroll
                for (int bj = 0; bj < 2; ++bj) { const size_t off = (size_t)(row0 + ai * HALF + m * 16) * 2048 + col0 + bj * HALF; g[m][bj] = __builtin_nontemporal_load((const u32x4*)(G + off)); t[m][bj] = __builtin_nontemporal_load((const u32x4*)(T + off)); }
#pragma unroll
            for (int m = 0; m < 4; ++m)
#pragma unroll
                for (int bj = 0; bj < 2; ++bj) *(u32x4*)(O + blk(row0 + ai * HALF + m * 16, col0 + bj * HALF, 2048)) = pack8f(lo4(t[m][bj]) + lo4(g[m][bj]) * acc[ai][bj][m][0], hi4(t[m][bj]) + hi4(g[m][bj]) * acc[ai][bj][m][1]); }
    }
};

template <class Epi, class Sched, bool ALIGN_EPI = false, bool SP2 = false>
__device__ __forceinline__ void gemm_phase(PG8_LAS unsigned char* lds, const Gemm g, const Sched& S, const Epi& E) {
    int tid_ = threadIdx.x; asm volatile("" : "+v"(tid_));
    const int tid = tid_, wid = __builtin_amdgcn_readfirstlane(tid >> 6), lane = tid & 63, wr = wid >> 2, wc = wid & 3, fr = lane & 15, fq = lane >> 4;
    const int K = g.K, nt = K / BK;
    unsigned voffA[2], voffB[2];
#pragma unroll
    for (int i = 0; i < 2; ++i) { int R, C; stage_rc(tid * 16 + i * 8192, R, C); const int Rb = Epi::PERM ? ((R & ~31) + perm32(R & 31)) : R;
        voffA[i] = (unsigned)(g.ablk ? (R * 64 + C) : (R * K + C)) * 2u; voffB[i] = (unsigned)(g.bblk ? (Rb * 64 + C) : (Rb * K + C)) * 2u; }
    const size_t kstepA = g.ablk ? (size_t)(BM * BK * 2) : (size_t)(BK * 2), kstepB = g.bblk ? (size_t)(BM * BK * 2) : (size_t)(BK * 2);
    const size_t hstepA = g.ablk ? (size_t)(HALF * BK * 2) : (size_t)HALF * K * 2, hstepB = g.bblk ? (size_t)(HALF * BK * 2) : (size_t)HALF * K * 2;
    const size_t tstep = (size_t)BM * K * 2;
    const unsigned ldsw = (unsigned)wid * 1024u;
    const int aoff = lds_byte(wr * 64 + fr, fq * 8), boff = lds_byte(wc * 32 + fr, fq * 8);
#define PG8_SA(b, h) (((b) * 2 + (h)) * HTB)
#define PG8_SB(b, h) ((4 + (b) * 2 + (h)) * HTB)
#define PG8_STAGE(bufoff, gbase, voff) do { _Pragma("unroll") for (int _i = 0; _i < 2; ++_i) \
        __builtin_amdgcn_global_load_lds((const unsigned*)((const char*)(gbase) + (voff)[_i]), (PG8_LAS unsigned*)(lds + (bufoff) + ldsw + _i * 8192), 16, 0, 0); } while (0)
#define PG8_LDA(dst, b, h) do { _Pragma("unroll") for (int m = 0; m < 4; ++m) _Pragma("unroll") for (int k = 0; k < 2; ++k) dst[m][k] = *(const PG8_LAS bf16x8*)(lds + PG8_SA(b, h) + aoff + m * 2048 + k * 1024); } while (0)
#define PG8_LDB(dst, b, h) do { _Pragma("unroll") for (int n = 0; n < 2; ++n) _Pragma("unroll") for (int k = 0; k < 2; ++k) dst[n][k] = *(const PG8_LAS bf16x8*)(lds + PG8_SB(b, h) + boff + n * 2048 + k * 1024); } while (0)
#define PG8_MMA(ai, bj, At, Bt) do { __builtin_amdgcn_s_setprio(1); _Pragma("unroll") for (int m = 0; m < 4; ++m) _Pragma("unroll") for (int n = 0; n < 2; ++n) _Pragma("unroll") for (int k = 0; k < 2; ++k) \
        acc[ai][bj][m][n] = __builtin_amdgcn_mfma_f32_16x16x32_bf16(Bt[n][k], At[m][k], acc[ai][bj][m][n], 0, 0, 0); __builtin_amdgcn_s_setprio(0); } while (0)
#define PG8_WAIT_V(n) asm volatile("s_waitcnt vmcnt(" #n ")" ::: "memory")
#define PG8_WAIT_L(n) asm volatile("s_waitcnt lgkmcnt(" #n ")" ::: "memory")
#define PG8_BAR __builtin_amdgcn_s_barrier()
#define PG8_SCHED __builtin_amdgcn_sched_barrier(0)
    Unit cur, nxt; int ui = 0;
    if (!S.next(0, cur)) return;
    f32x4 acc[2][2][4][2];
#pragma unroll
    for (int a = 0; a < 2; ++a)
#pragma unroll
        for (int b = 0; b < 2; ++b)
#pragma unroll
            for (int m = 0; m < 4; ++m)
#pragma unroll
                for (int n = 0; n < 2; ++n) acc[a][b][m][n] = (f32x4){0.f, 0.f, 0.f, 0.f};
    bf16x8 At[4][2], B0[2][2], B1[2][2];
    const char* cA = (const char*)g.A + (size_t)cur.pm * tstep; const char* cB = (const char*)g.Bt + (size_t)cur.pn * tstep;
    S.a_ready(cur);
    if constexpr (SP2) {
        PG8_STAGE(PG8_SB(0, 0), cB, voffB); PG8_STAGE(PG8_SB(0, 1), cB + hstepB, voffB); PG8_STAGE(PG8_SA(0, 0), cA, voffA); PG8_STAGE(PG8_SA(0, 1), cA + hstepA, voffA);
        if (wr == 1) PG8_BAR;
        PG8_WAIT_V(2); PG8_BAR;
        PG8_STAGE(PG8_SB(1, 0), cB + kstepB, voffB); PG8_STAGE(PG8_SA(1, 0), cA + kstepA, voffA); PG8_STAGE(PG8_SB(1, 1), cB + hstepB + kstepB, voffB);
        PG8_WAIT_V(6); PG8_BAR;
    } else {
        PG8_STAGE(PG8_SB(0, 0), cB, voffB); PG8_STAGE(PG8_SA(0, 0), cA, voffA); PG8_STAGE(PG8_SB(0, 1), cB + hstepB, voffB); PG8_STAGE(PG8_SA(0, 1), cA + hstepA, voffA);
        if (wr == 1) PG8_BAR;
        PG8_WAIT_V(4); PG8_BAR;
        PG8_STAGE(PG8_SB(1, 0), cB + kstepB, voffB); PG8_STAGE(PG8_SA(1, 0), cA + kstepA, voffA); PG8_STAGE(PG8_SB(1, 1), cB + hstepB + kstepB, voffB);
        PG8_WAIT_V(6); PG8_BAR;
    }
    for (;;) {
        const bool has_next = S.next(ui + 1, nxt);
        const char* nA = has_next ? (const char*)g.A + (size_t)nxt.pm * tstep : cA; const char* nB = has_next ? (const char*)g.Bt + (size_t)nxt.pn * tstep : cB;
        for (int t = 0; t < nt; t += 2) {
            const bool last = (t == nt - 2);
            const char* a1 = cA + (size_t)(t + 1) * kstepA;
            const char* a2 = last ? nA : cA + (size_t)(t + 2) * kstepA; const char* b2 = last ? nB : cB + (size_t)(t + 2) * kstepB;
            const char* a3 = a2 + kstepA; const char* b3 = b2 + kstepB;
            if (last && has_next) S.a_ready(nxt);
            if constexpr (SP2) {
            PG8_LDB(B0, 0, 0); PG8_LDB(B1, 0, 1); PG8_SCHED; PG8_LDA(At, 0, 0); PG8_STAGE(PG8_SA(1, 1), a1 + hstepA, voffA);
            PG8_WAIT_V(8); PG8_WAIT_L(0); PG8_BAR; PG8_MMA(0, 0, At, B0); PG8_MMA(0, 1, At, B1); PG8_BAR; PG8_SCHED;
            PG8_LDA(At, 0, 1); PG8_STAGE(PG8_SB(0, 0), b2, voffB); PG8_STAGE(PG8_SB(0, 1), b2 + hstepB, voffB); PG8_STAGE(PG8_SA(0, 0), a2, voffA);
            PG8_WAIT_V(8); PG8_WAIT_L(0); PG8_BAR; PG8_MMA(1, 0, At, B0); PG8_MMA(1, 1, At, B1); PG8_BAR; PG8_SCHED;
            PG8_LDB(B0, 1, 0); PG8_LDB(B1, 1, 1); PG8_SCHED; PG8_LDA(At, 1, 0); PG8_STAGE(PG8_SA(0, 1), a2 + hstepA, voffA);
            PG8_WAIT_V(8); PG8_WAIT_L(0); PG8_BAR; PG8_MMA(0, 0, At, B0); PG8_MMA(0, 1, At, B1); PG8_BAR; PG8_SCHED;
            PG8_LDA(At, 1, 1); PG8_STAGE(PG8_SB(1, 0), b3, voffB); PG8_STAGE(PG8_SB(1, 1), b3 + hstepB, voffB); PG8_STAGE(PG8_SA(1, 0), a3, voffA);
            PG8_WAIT_V(8); PG8_WAIT_L(0); PG8_BAR; PG8_MMA(1, 0, At, B0); PG8_MMA(1, 1, At, B1); PG8_BAR; PG8_SCHED;
            } else {
            PG8_LDB(B0, 0, 0); PG8_SCHED; PG8_LDA(At, 0, 0); PG8_STAGE(PG8_SA(1, 1), a1 + hstepA, voffA);
            PG8_WAIT_L(8); PG8_BAR; PG8_WAIT_L(0); PG8_MMA(0, 0, At, B0); PG8_BAR; PG8_SCHED;
            PG8_LDB(B1, 0, 1); PG8_STAGE(PG8_SB(0, 0), b2, voffB);
            PG8_BAR; PG8_WAIT_L(0); PG8_MMA(0, 1, At, B1); PG8_BAR;
            PG8_LDA(At, 0, 1); PG8_STAGE(PG8_SA(0, 0), a2, voffA);
            PG8_BAR; PG8_WAIT_L(0); PG8_MMA(1, 0, At, B0); PG8_BAR; PG8_SCHED;
            PG8_STAGE(PG8_SB(0, 1), b2 + hstepB, voffB);
            PG8_WAIT_V(6); PG8_BAR; PG8_MMA(1, 1, At, B1); PG8_BAR;
            PG8_LDB(B0, 1, 0); PG8_SCHED; PG8_LDA(At, 1, 0); PG8_STAGE(PG8_SA(0, 1), a2 + hstepA, voffA);
            PG8_WAIT_L(8); PG8_BAR; PG8_WAIT_L(0); PG8_MMA(0, 0, At, B0); PG8_BAR; PG8_SCHED;
            PG8_LDB(B1, 1, 1); PG8_STAGE(PG8_SB(1, 0), b3, voffB);
            PG8_BAR; PG8_WAIT_L(0); PG8_MMA(0, 1, At, B1); PG8_BAR;
            PG8_LDA(At, 1, 1); PG8_STAGE(PG8_SA(1, 0), a3, voffA);
            PG8_BAR; PG8_WAIT_L(0); PG8_MMA(1, 0, At, B0); PG8_BAR; PG8_SCHED;
            PG8_STAGE(PG8_SB(1, 1), b3 + hstepB, voffB);
            PG8_WAIT_V(6); PG8_BAR; PG8_MMA(1, 1, At, B1); PG8_BAR;
            }
        }
        if constexpr (ALIGN_EPI) { if (wr == 0) PG8_BAR; }
        if constexpr (!Epi::AFTER_DRAIN) { E(acc, cur, wr, wc, fr, fq); S.done(cur); }
        if (!has_next) break;
#pragma unroll
        for (int a = 0; a < 2; ++a)
#pragma unroll
            for (int b = 0; b < 2; ++b)
#pragma unroll
                for (int m = 0; m < 4; ++m)
#pragma unroll
                    for (int n = 0; n < 2; ++n) acc[a][b][m][n] = (f32x4){0.f, 0.f, 0.f, 0.f};
        cur = nxt; cA = nA; cB = nB; ++ui;
        if constexpr (ALIGN_EPI) { if (wr == 1) PG8_BAR; }
    }
    PG8_WAIT_V(0);
    if constexpr (!ALIGN_EPI) { if (wr == 0) PG8_BAR; }
    PG8_BAR;
    if constexpr (Epi::AFTER_DRAIN) { E.fused(acc, cur, wr, wc, fr, fq, lds, wid, lane); S.done(cur); }
#undef PG8_SA
#undef PG8_SB
#undef PG8_STAGE
#undef PG8_LDA
#undef PG8_LDB
#undef PG8_MMA
#undef PG8_WAIT_V
#undef PG8_WAIT_L
#undef PG8_BAR
#undef PG8_SCHED
}
}
namespace ab {
constexpr int D = 128;
constexpr float THR = 8.f;
constexpr bool WSKIP = false;
constexpr float SCALE = 0.08838834764831845f;
constexpr int NW = 8, QBLK = 32, KVBLK = 64, QB = NW * QBLK;
constexpr int SHM_V = KVBLK * D * 2, SHM_K = KVBLK * D * 2;
constexpr int LDS_BYTES = 2 * SHM_V + 2 * SHM_K + NW * 64 * 4;
using bf16 = __hip_bfloat16;
typedef short bf16x8 __attribute__((ext_vector_type(8)));
typedef short s16x4 __attribute__((ext_vector_type(4)));
typedef float f32x16 __attribute__((ext_vector_type(16)));
typedef float f32x4 __attribute__((ext_vector_type(4)));
typedef unsigned u32x4 __attribute__((ext_vector_type(4)));
template <class A, class Bt> struct same_t { static constexpr bool v = false; };
template <class A> struct same_t<A, A> { static constexpr bool v = true; };
#define KSWZ(row, colB) ((row) * 256 + ((colB) ^ (((row) & 7) << 4)))
#define SBAR() __builtin_amdgcn_sched_barrier(0)
__device__ __forceinline__ int v_st(int k, int c) { const int kk = (k & ~0xC) | ((k & 4) << 1) | ((k & 8) >> 1); return ((kk >> 3) * 4 + (c >> 5)) * 512 + ((kk & 7) * 32 + (c & 31)) * 2; }
__device__ __forceinline__ int v_rd_base(int lane) { return ((lane & 3) << 3) | (((lane >> 2) & 3) << 6) | (((lane >> 4) & 1) << 5) | (((lane >> 5) & 1) << 8); }
constexpr int v_rd_off(int d0, int ks, int half) { return d0 * 512 + ks * 4096 + half * 2048; }
__device__ __forceinline__ int crow(int r, int hi) { return (r & 3) + 8 * (r >> 2) + 4 * hi; }
__device__ __forceinline__ unsigned cvtpk(float lo, float hi) {
    unsigned r; asm volatile("v_cvt_pk_bf16_f32 %0, %1, %2" : "=v"(r) : "v"(lo), "v"(hi)); return r;
}
__device__ __forceinline__ bf16x8 pack8(f32x4 a, f32x4 b) {
    u32x4 w = {cvtpk(a[0], a[1]), cvtpk(a[2], a[3]), cvtpk(b[0], b[1]), cvtpk(b[2], b[3])};
    return *reinterpret_cast<bf16x8*>(&w);
}
template <class T> __device__ __forceinline__ bf16x8 load8(const T* p) {
    if constexpr (same_t<T, float>::v) { return pack8(*(const f32x4*)p, *(const f32x4*)(p + 4)); }
    else { return *reinterpret_cast<const bf16x8*>(p); }
}
__device__ __forceinline__ void mask_tile(f32x16& p0, f32x16& p1, int dq, unsigned W) {
    const float NEG = -__builtin_inff();
#pragma unroll
    for (int r = 0; r < 16; ++r) {
        const int c = (r & 3) + 8 * (r >> 2);
        if ((unsigned)(dq - c) >= W) p0[r] = NEG;
        if ((unsigned)(dq - c - 32) >= W) p1[r] = NEG;
    }
}
__device__ __forceinline__ void partialSM(f32x16& p0, f32x16& p1, float& m_reg, float& mn, float& alpha) {
    float pmax = p0[0]; for (int r = 1; r < 16; ++r) pmax = fmaxf(pmax, p0[r]); for (int r = 0; r < 16; ++r) pmax = fmaxf(pmax, p1[r]);
    { auto rr = __builtin_amdgcn_permlane32_swap(__float_as_uint(pmax), __float_as_uint(pmax), false, false);
      pmax = fmaxf(__uint_as_float(rr[0]), __uint_as_float(rr[1])); }
    constexpr float C2 = 1.4426950408889634f * SCALE;
    if (__builtin_expect(__all((pmax - m_reg) * SCALE <= THR), 1)) { mn = m_reg; alpha = 1.f; }
    else { mn = fmaxf(m_reg, pmax); alpha = __builtin_amdgcn_exp2f((m_reg - mn) * C2); m_reg = mn; }
    const float mnL = -mn * C2;
    for (int r = 0; r < 16; ++r) p0[r] = fmaf(p0[r], C2, mnL); for (int r = 0; r < 16; ++r) p1[r] = fmaf(p1[r], C2, mnL);
    for (int r = 0; r < 16; ++r) p0[r] = __builtin_amdgcn_exp2f(p0[r]);
}
__device__ __forceinline__ void finishSM(f32x16& p0, f32x16& p1, float alpha, float& l_reg, bf16x8& pa0, bf16x8& pa1, bf16x8& pa2, bf16x8& pa3) {
    for (int r = 0; r < 16; ++r) p1[r] = __builtin_amdgcn_exp2f(p1[r]);
    float ps = 0; for (int r = 0; r < 16; ++r) ps += p0[r]; for (int r = 0; r < 16; ++r) ps += p1[r];
    { auto rr = __builtin_amdgcn_permlane32_swap(__float_as_uint(ps), __float_as_uint(ps), false, false);
      ps = __uint_as_float(rr[0]) + __uint_as_float(rr[1]); }
    l_reg = l_reg * alpha + ps;
#define PK4(P, B_, OUT) do { unsigned a0 = cvtpk(P[B_+0], P[B_+1]), a1 = cvtpk(P[B_+2], P[B_+3]);                          \
        unsigned b0 = cvtpk(P[B_+4], P[B_+5]), b1 = cvtpk(P[B_+6], P[B_+7]);                                             \
        auto r0 = __builtin_amdgcn_permlane32_swap(a0, b0, false, false); auto r1 = __builtin_amdgcn_permlane32_swap(a1, b1, false, false); \
        u32x4 w = {r0[0], r1[0], r0[1], r1[1]}; OUT = *reinterpret_cast<bf16x8*>(&w); } while (0)
    PK4(p0, 0, pa0); PK4(p0, 8, pa1); PK4(p1, 0, pa2); PK4(p1, 8, pa3);
#undef PK4
}
template <int KB, bool SK>
__device__ __forceinline__ void qkt(f32x16& p0, f32x16& p1, const char* K_lds, int r32, int hi, const bf16x8* qr, bool act) {
    if (SK && !act) { const float NEG = -__builtin_inff();
#pragma unroll
        for (int r = 0; r < 16; ++r) { p0[r] = NEG; p1[r] = NEG; } return; }
    p0 = f32x16{}; p1 = f32x16{};
    const char* kb[4];
#pragma unroll
    for (int dd = 0; dd < 4; ++dd) kb[dd] = K_lds + KB * SHM_K + KSWZ(r32, (dd * 16 + hi * 8) * 2);
#pragma unroll
    for (int d0 = 0; d0 < 8; ++d0) { const char* a = kb[d0 & 3] + (d0 >> 2) * 128;
        bf16x8 b0 = *reinterpret_cast<const bf16x8*>(a);
        bf16x8 b1 = *reinterpret_cast<const bf16x8*>(a + 32 * 256);
        p0 = __builtin_amdgcn_mfma_f32_32x32x16_bf16(b0, qr[d0], p0, 0, 0, 0);
        p1 = __builtin_amdgcn_mfma_f32_32x32x16_bf16(b1, qr[d0], p1, 0, 0, 0); }
}
template <int VB, bool SK>
__device__ __forceinline__ void pv_tile(f32x16* o, int vb0, bf16x8 pa0, bf16x8 pa1, bf16x8 pa2, bf16x8 pa3, bool act) {
    if (SK && !act) return;
#define TRRD(dst, off) asm volatile("ds_read_b64_tr_b16 %0, %1 offset:%2" : "=&v"(dst) : "v"(vb0), "i"(off) : "memory")
#define PV_D0(d0) do { s16x4 l0, l1, l2, l3, h0, h1, h2, h3; constexpr int b_ = VB * SHM_V + v_rd_off(d0, 0, 0);     \
        TRRD(l0, b_); TRRD(h0, b_ + 2048); TRRD(l1, b_ + 4096); TRRD(h1, b_ + 6144); TRRD(l2, b_ + 8192); TRRD(h2, b_ + 10240); TRRD(l3, b_ + 12288); TRRD(h3, b_ + 14336); \
        asm volatile("s_waitcnt lgkmcnt(0)" ::: "memory"); SBAR();                 \
        o[d0] = __builtin_amdgcn_mfma_f32_32x32x16_bf16(pa0, (bf16x8){l0[0], l0[1], l0[2], l0[3], h0[0], h0[1], h0[2], h0[3]}, o[d0], 0, 0, 0);   \
        o[d0] = __builtin_amdgcn_mfma_f32_32x32x16_bf16(pa1, (bf16x8){l1[0], l1[1], l1[2], l1[3], h1[0], h1[1], h1[2], h1[3]}, o[d0], 0, 0, 0);   \
        o[d0] = __builtin_amdgcn_mfma_f32_32x32x16_bf16(pa2, (bf16x8){l2[0], l2[1], l2[2], l2[3], h2[0], h2[1], h2[2], h2[3]}, o[d0], 0, 0, 0);   \
        o[d0] = __builtin_amdgcn_mfma_f32_32x32x16_bf16(pa3, (bf16x8){l3[0], l3[1], l3[2], l3[3], h3[0], h3[1], h3[2], h3[3]}, o[d0], 0, 0, 0); } while (0)
    PV_D0(0); PV_D0(1); PV_D0(2); PV_D0(3);
#undef PV_D0
#undef TRRD
}

template <class TIn, class TOut> struct BlockRef { const TIn* Q; const TIn* K; const TIn* V; TOut* O; int P0; };
template <class TIn> struct Seam {
    bf16x8 qr[8];
    bf16x8 st_v0, st_v1, st_k0, st_k1; f32x4 sf0, sf1, sf2, sf3;
    f32x4 tq[16];
};
__device__ __forceinline__ int swa_jlo(int P0, int W) { const int lowk = P0 - W + 1; return lowk > 0 ? lowk / KVBLK : 0; }
#define ROW(p, k0, rr) ((p) + (size_t)((k0) + (rr)) * KVP + sc)
#define VMW() asm volatile("s_waitcnt vmcnt(0)" ::: "memory")
#define VMWN(n) asm volatile("s_waitcnt vmcnt(%0)" :: "i"(n) : "memory")
#define SLOAD_H(Kp, Vp, k0) do { S.st_v0 = load8<TIn>(ROW(Vp, k0, sr)); S.st_v1 = load8<TIn>(ROW(Vp, k0, 32 + sr));              \
                         S.st_k0 = load8<TIn>(ROW(Kp, k0, sr)); S.st_k1 = load8<TIn>(ROW(Kp, k0, 32 + sr)); } while (0)
#define SWRITE_HK(bf) do { *(bf16x8*)(K_lds + (bf) * SHM_K + kws) = S.st_k0; *(bf16x8*)(K_lds + (bf) * SHM_K + kws + 32 * 256) = S.st_k1; } while (0)
#define SWRITE_HV(bf) do { *(bf16x8*)(V_lds + (bf) * SHM_V + vst0) = S.st_v0; *(bf16x8*)(V_lds + (bf) * SHM_V + vst1) = S.st_v1; } while (0)
#define SWRITE_H(bf) do { SWRITE_HV(bf); SWRITE_HK(bf); } while (0)
#define SLOAD_F(p, k0) do { S.sf0 = *(const f32x4*)ROW(p, k0, sr); S.sf1 = *(const f32x4*)(ROW(p, k0, sr) + 4);                \
                            S.sf2 = *(const f32x4*)ROW(p, k0, 32 + sr); S.sf3 = *(const f32x4*)(ROW(p, k0, 32 + sr) + 4); } while (0)
#define SWRITE_KF(bf) do { *(bf16x8*)(K_lds + (bf) * SHM_K + kws) = pack8(S.sf0, S.sf1); *(bf16x8*)(K_lds + (bf) * SHM_K + kws + 32 * 256) = pack8(S.sf2, S.sf3); } while (0)
#define SWRITE_VF(bf) do { *(bf16x8*)(V_lds + (bf) * SHM_V + vst0) = pack8(S.sf0, S.sf1); *(bf16x8*)(V_lds + (bf) * SHM_V + vst1) = pack8(S.sf2, S.sf3); } while (0)
template <class TIn, class TOut, int QP, int KVP, int OP>
__device__ __forceinline__ void causal_swa_prime(const BlockRef<TIn, TOut>& cur, int W, char* lds, Seam<TIn>& S) {
    constexpr bool F32 = same_t<TIn, float>::v;
    int tid_ = threadIdx.x; asm volatile("" : "+v"(tid_));
    const int tid = tid_, wid = __builtin_amdgcn_readfirstlane(tid >> 6), lane = tid & 63, r32 = lane & 31, hi = lane >> 5;
    const int sr = tid >> 4, sc = (tid & 15) * 8, kws = KSWZ(sr, sc * 2); char* K_lds = lds + 2 * SHM_V;
    const int kb0 = swa_jlo(cur.P0, W) * KVBLK;
    for (int d0 = 0; d0 < 8; ++d0) S.qr[d0] = load8<TIn>(cur.Q + (size_t)(wid * QBLK + r32) * QP + d0 * 16 + hi * 8);
    if constexpr (F32) { SLOAD_F((const float*)cur.K, kb0); VMW(); SWRITE_KF(0); SBAR(); SLOAD_F((const float*)cur.V, kb0); }
    else { SLOAD_H(cur.K, cur.V, kb0); VMW(); SWRITE_HK(0); }
    __syncthreads();
}
template <class TIn, class TOut, int QP, int KVP, int OP>
__device__ __forceinline__ void causal_swa_block(const BlockRef<TIn, TOut>& cur, const BlockRef<TIn, TOut>& nxt, int skv, int W, char* lds, Seam<TIn>& S) {
    constexpr bool F32 = same_t<TIn, float>::v;
    int tid_ = threadIdx.x; asm volatile("" : "+v"(tid_));
    const int tid = tid_, wid = __builtin_amdgcn_readfirstlane(tid >> 6), lane = tid & 63, r32 = lane & 31, hi = lane >> 5;
    const int j_lo = swa_jlo(cur.P0, W);
    int j_hi = (cur.P0 + QB - 1) / KVBLK + 1; if (j_hi > skv / KVBLK) j_hi = skv / KVBLK;
    const int NT = j_hi - j_lo;
    const int kbn = swa_jlo(nxt.P0, W) * KVBLK;
    const int qlo = cur.P0 + wid * QBLK, qm = qlo + r32 - 4 * hi;
    char* V_lds = lds; char* K_lds = lds + 2 * SHM_V;
    float* ws = (float*)(lds + 2 * SHM_V + 2 * SHM_K) + wid * 64; float* li_l = ws, * al_l = ws + 32;
    float m_reg = -1e30f, l_reg = 0; f32x16 o[4] = {};
    const int sr = tid >> 4, sc = (tid & 15) * 8, vst0 = v_st(sr, sc), vst1 = v_st(32 + sr, sc), kws = KSWZ(sr, sc * 2);
    const int vb0 = (int)(uintptr_t)V_lds + v_rd_base(lane);
    const TIn* Kh = cur.K; const TIn* Vh = cur.V;
#define RESC(a) do { if (__any((a) < 1.f)) { if (hi == 0) al_l[r32] = (a); asm volatile("s_waitcnt lgkmcnt(0)" ::: "memory");              \
                     for (int d_ = 0; d_ < 4; ++d_) for (int r = 0; r < 16; ++r) o[d_][r] *= al_l[crow(r, hi)]; } } while (0)
#define KBASE(t) ((j_lo + (t)) * KVBLK)
#define ACT(t) (KBASE(t) <= qlo + QBLK - 1 && KBASE(t) + KVBLK - 1 >= qlo - W + 1)
#define MASKT(P0_, P1_, t) do { const int kb_ = KBASE(t); if ((!SK || ACT(t)) && (kb_ + KVBLK - 1 > qlo || kb_ <= qlo + QBLK - 1 - W)) mask_tile(P0_, P1_, qm - kb_, (unsigned)W); } while (0)
    constexpr int NQL = F32 ? 16 : 8;
    constexpr bool SK = WSKIP && !F32;
#define SEAM_K0() do { VMWN(NQL); if constexpr (F32) { SWRITE_KF(0); SBAR(); SLOAD_F((const float*)nxt.V, kbn); } else { SWRITE_HK(0); } SBAR(); } while (0)
    f32x16 pA0, pA1, pB0, pB1; float mnA, mnB, alA, alB; bf16x8 pa0, pa1, pa2, pa3;
    if constexpr (F32) { VMW(); SWRITE_VF(0); SBAR(); } else { SWRITE_HV(0); SBAR(); }
    if (NT > 1) { if constexpr (F32) SLOAD_F((const float*)Kh, KBASE(1)); else SLOAD_H(Kh, Vh, KBASE(1)); }
    SBAR(); qkt<0, SK>(pA0, pA1, K_lds, r32, hi, S.qr, ACT(0));
    if constexpr (F32) { if (NT > 1) { VMW(); SWRITE_KF(1); SBAR(); SLOAD_F((const float*)Vh, KBASE(1)); } }
    MASKT(pA0, pA1, 0); partialSM(pA0, pA1, m_reg, mnA, alA);
    if (NT > 1) { VMW(); if constexpr (F32) { SWRITE_VF(1); SBAR(); if (NT > 2) SLOAD_F((const float*)Kh, KBASE(2)); } else SWRITE_H(1); }
    __syncthreads();
#define HALF_STEP(PX0, PX1, mnX, alX, PY0, PY1, alY, t, KB, VB, SB) do {                                                      \
        SBAR(); qkt<KB, SK>(PX0, PX1, K_lds, r32, hi, S.qr, ACT(t));                                             \
        finishSM(PY0, PY1, alY, l_reg, pa0, pa1, pa2, pa3); SBAR();                                                           \
        if ((t) + 1 < NT) { if constexpr (F32) { VMW(); SWRITE_KF(SB); SBAR(); SLOAD_F((const float*)Vh, KBASE((t) + 1)); }  \
                            else { SLOAD_H(Kh, Vh, KBASE((t) + 1)); } SBAR(); }                                               \
        pv_tile<VB, SK>(o, vb0, pa0, pa1, pa2, pa3, ACT((t) - 1)); MASKT(PX0, PX1, (t)); partialSM(PX0, PX1, m_reg, mnX, alX);                                        \
        __syncthreads();                                                                                                      \
        if ((t) + 1 < NT) { VMW(); if constexpr (F32) { SWRITE_VF(SB); SBAR(); if ((t) + 2 < NT) SLOAD_F((const float*)Kh, KBASE((t) + 2)); } \
                            else { SWRITE_H(SB); } }                                                                          \
        RESC(alX); __syncthreads(); } while (0)
    for (int t = 1; t + 1 < NT; t += 2) {
        HALF_STEP(pB0, pB1, mnB, alB, pA0, pA1, alA, t, 1, 0, 0);
        HALF_STEP(pA0, pA1, mnA, alA, pB0, pB1, alB, t + 1, 0, 1, 1);
    }
    const bool even = (NT & 1) == 0;
    if (even) { SBAR(); qkt<1, SK>(pB0, pB1, K_lds, r32, hi, S.qr, ACT(NT - 1)); SBAR(); }
#define QROW(e) (nxt.Q + (size_t)(wid * QBLK + r32) * QP + ((e) >> 1) * 16 + hi * 8 + ((e) & 1) * 4)
    if constexpr (F32) { SLOAD_F((const float*)nxt.K, kbn); SBAR();
#pragma unroll
        for (int e = 0; e < 8; ++e) S.tq[e] = *(const f32x4*)QROW(e); }
    else { SLOAD_H(nxt.K, nxt.V, kbn); SBAR();
#pragma unroll
        for (int d0 = 0; d0 < 8; ++d0) S.qr[d0] = load8<TIn>(nxt.Q + (size_t)(wid * QBLK + r32) * QP + d0 * 16 + hi * 8); }
    SBAR();
    finishSM(pA0, pA1, alA, l_reg, pa0, pa1, pa2, pa3); SBAR();
    if constexpr (F32) {
#pragma unroll
        for (int e = 8; e < 16; ++e) S.tq[e] = *(const f32x4*)QROW(e); SBAR(); }
#undef QROW
    pv_tile<0, SK>(o, vb0, pa0, pa1, pa2, pa3, ACT(even ? NT - 2 : NT - 1));
    if (even) { MASKT(pB0, pB1, NT - 1); partialSM(pB0, pB1, m_reg, mnB, alB); __syncthreads(); RESC(alB);
        finishSM(pB0, pB1, alB, l_reg, pa0, pa1, pa2, pa3); SBAR(); pv_tile<1, SK>(o, vb0, pa0, pa1, pa2, pa3, ACT(NT - 1)); }
    SBAR(); SEAM_K0();
    if (hi == 0) li_l[r32] = l_reg; asm volatile("s_waitcnt lgkmcnt(0)" ::: "memory");
    float rli[16];
#pragma unroll
    for (int r = 0; r < 16; ++r) rli[r] = __builtin_amdgcn_rcpf(li_l[crow(r, hi)]);
    TOut* Ow = cur.O + (size_t)(wid * QBLK) * OP;
#pragma unroll
    for (int r = 0; r < 16; ++r) { const int orow = crow(r, hi);
#pragma unroll
        for (int d0 = 0; d0 < 4; ++d0) { const float v = o[d0][r] * rli[r];
            if constexpr (same_t<TOut, float>::v) { Ow[(size_t)orow * OP + d0 * 32 + r32] = v; }
            else { const float vn = __shfl_xor(v, 1);
                   if ((r32 & 1) == 0) *(unsigned*)(Ow + (size_t)orow * OP + d0 * 32 + r32) = cvtpk(v, vn); } } }
    if constexpr (F32) {
#pragma unroll
        for (int d0 = 0; d0 < 8; ++d0) S.qr[d0] = pack8(S.tq[2 * d0], S.tq[2 * d0 + 1]); }
    __syncthreads();
#undef RESC
#undef KBASE
#undef ACT
#undef MASKT
#undef SEAM_K0
#undef HALF_STEP
}
#undef ROW
#undef VMW
#undef VMWN
#undef SLOAD_H
#undef SWRITE_HK
#undef SWRITE_HV
#undef SWRITE_H
#undef SLOAD_F
#undef SWRITE_KF
#undef SWRITE_VF
#undef SBAR
}

#define LAS __attribute__((address_space(3)))
typedef unsigned short bf16;
typedef unsigned v4u __attribute__((ext_vector_type(4)));
typedef unsigned v2u __attribute__((ext_vector_type(2)));
typedef float f32x4 __attribute__((ext_vector_type(4)));
constexpr int NWAVES = 8;
constexpr int BATCH = 4, SEQ = 2048, DM = 2048, M = BATCH * SEQ, DFF = 5504, NMIX = 16384, MEML = 256, MM = BATCH * MEML, XW = 512;
constexpr float NORM_EPS = 1e-6f, SUBLN_EPS = 1e-5f, LAM_INIT = 0.2f;
constexpr size_t MiB = 1u << 20;
constexpr size_t WS_WMIX = 1 * MiB, WS_WA = 65 * MiB, WS_WC = 73 * MiB, WS_WMO = 81 * MiB, WS_WXQ = 89 * MiB, WS_WXKV = 91 * MiB, WS_WXO = 95 * MiB;
constexpr size_t WS_WGU = 97 * MiB, WS_WD = 140 * MiB;
constexpr size_t WS_H = 162 * MiB, WS_MH = 194 * MiB, WS_XKV = 198 * MiB, WS_XQ = 200 * MiB, WS_XO = 208 * MiB;
constexpr size_t WS_Q = 216 * MiB, WS_K = 248 * MiB, WS_V = 280 * MiB, WS_BG = 312 * MiB, WS_CU = 344 * MiB, WS_GA = 376 * MiB, WS_GC = 408 * MiB, WS_OA = 440 * MiB, WS_OB = 472 * MiB;
constexpr size_t WS_YA = WS_Q, WS_YC = WS_K, WS_T = WS_V, WS_MRG = WS_CU, WS_ACT = WS_Q;
constexpr size_t WS_XB = WS_H, WS_SS = 504 * MiB;
constexpr size_t WS_END = 505 * MiB;
constexpr int LDS_BYTES = 147456;

__device__ __forceinline__ unsigned f2bf(float f) { unsigned u = __builtin_bit_cast(unsigned, f); return (u + 0x7fffu + ((u >> 16) & 1u)) >> 16; }
__device__ __forceinline__ unsigned pk2(float lo, float hi) { return f2bf(lo) | (f2bf(hi) << 16); }
__device__ __forceinline__ float wave_sum(float v) {
#pragma unroll
    for (int o = 1; o < 64; o <<= 1) v += __shfl_xor(v, o);
    return v;
}
template <int MODE> __device__ __forceinline__ int drow_map(int n0, int roff) {
    if (MODE == 0) return n0 + roff;
    if (MODE == 1) return (n0 >> 7) * 256 + roff + (n0 & 127);
    if (n0 < 8192 || n0 >= 12288) return n0;
    const int which = n0 >= 10240, j = n0 - (which ? 10240 : 8192);
    return 8192 + (j >> 7) * 256 + which * 128 + (j & 127);
}
__device__ __forceinline__ void transpose_item(const float* W, int K, int N, bf16* WT, int k0, int n0, int drow0, const float* g, LAS float* scr, int lane) {
#pragma unroll 8
    for (int i = 0; i < 32; ++i) { const int kk = 2 * i + (lane >> 5); scr[kk * 33 + (lane & 31)] = __builtin_nontemporal_load(W + (size_t)(k0 + kk) * N + n0 + (lane & 31)); }
    const int c = lane & 7;
    f32x4 g0 = {1.f, 1.f, 1.f, 1.f}, g1 = g0;
    if (g) { g0 = *(const f32x4*)(g + k0 + 8 * c); g1 = *(const f32x4*)(g + k0 + 8 * c + 4); }
    asm volatile("s_waitcnt lgkmcnt(0)" ::: "memory");
#pragma unroll
    for (int j = 0; j < 4; ++j) { const int n = (lane >> 3) + 8 * j; const LAS float* sp = scr + (8 * c) * 33 + n;
        v4u o; o.x = pk2(sp[0 * 33] * g0.x, sp[1 * 33] * g0.y); o.y = pk2(sp[2 * 33] * g0.z, sp[3 * 33] * g0.w); o.z = pk2(sp[4 * 33] * g1.x, sp[5 * 33] * g1.y); o.w = pk2(sp[6 * 33] * g1.z, sp[7 * 33] * g1.w);
        *(v4u*)(WT + pg8::blk(drow0 + n, k0 + 8 * c, K)) = o; }
    asm volatile("s_waitcnt lgkmcnt(0)" ::: "memory");
}
template <int MODE> __device__ __forceinline__ void transpose_matrix(const float* W, int K, int N, bf16* WT, int roff, const float* g, LAS float* scr, int gw, int ngw, int lane, int it0 = 0, int it1 = 0x7fffffff) {
    const int nblk = N / 32, nitems = min((K / 64) * nblk, it1);
    for (int it = it0 + gw; it < nitems; it += ngw) { const int kb = it / nblk, nb = it - kb * nblk; transpose_item(W, K, N, WT, 64 * kb, 32 * nb, drow_map<MODE>(32 * nb, roff), g, scr, lane); }
}
__device__ __forceinline__ void rms_row_bf16(const float* xrow, const float* g, bf16* obase, int row, int lane) {
    const f32x4* xr = (const f32x4*)xrow + lane; const f32x4* gr = (const f32x4*)g + lane;
    f32x4 v[8]; float s = 0.f;
#pragma unroll
    for (int j = 0; j < 8; ++j) { v[j] = __builtin_nontemporal_load(xr + 64 * j); s += (v[j].x * v[j].x + v[j].y * v[j].y) + (v[j].z * v[j].z + v[j].w * v[j].w); }
    const float r = 1.0f / sqrtf(wave_sum(s) * (1.f / DM) + NORM_EPS);
#pragma unroll
    for (int j = 0; j < 8; ++j) { const f32x4 gg = gr[64 * j]; const f32x4 o = v[j] * r * gg; v2u w; w.x = pk2(o.x, o.y); w.y = pk2(o.z, o.w); *(v2u*)(obase + pg8::blk(row, 4 * lane + 256 * j, DM)) = w; }
}
__device__ __forceinline__ void rms_row_f32(const float* xrow, const float* g, float* orow, int lane) {
    const f32x4* xr = (const f32x4*)xrow + lane; const f32x4* gr = (const f32x4*)g + lane;
    f32x4 v[8]; float s = 0.f;
#pragma unroll
    for (int j = 0; j < 8; ++j) { v[j] = xr[64 * j]; s += (v[j].x * v[j].x + v[j].y * v[j].y) + (v[j].z * v[j].z + v[j].w * v[j].w); }
    const float r = 1.0f / sqrtf(wave_sum(s) * (1.f / DM) + NORM_EPS);
    f32x4* o = (f32x4*)orow + lane;
#pragma unroll
    for (int j = 0; j < 8; ++j) o[64 * j] = v[j] * r * gr[64 * j];
}

constexpr int CW_BAR = 4096;
constexpr size_t CTL_ZERO_BYTES = 65536;
constexpr int XBST_OFF = 139264 - 512;
constexpr int TAB_OFF = 139264;
__device__ __forceinline__ unsigned char* ldp(LAS unsigned char* ldsl, int i) {
    const unsigned long long v = ((LAS unsigned long long*)(ldsl + TAB_OFF))[i];
    unsigned lo = __builtin_amdgcn_readfirstlane((unsigned)v), hi = __builtin_amdgcn_readfirstlane((unsigned)(v >> 32));
    asm volatile("" : "+s"(lo), "+s"(hi));
    return (unsigned char*)(__attribute__((address_space(1))) unsigned char*)(((unsigned long long)hi << 32) | lo);
}
#define XB_TMO      128
#define XB_XCNT(j)  (256  + 64 * (j))
#define XB_XSUB(j)  (1280 + 64 * (j))
#define XB_XGEN(j)  (2304 + 64 * (j))
#define XB_TOP      3328
#define XB_TOPGEN   3392
#define XCD_BAR_WORDS 3456
#define XB_SPIN_CAP (1u << 18)

__device__ __forceinline__ unsigned xb_ld(unsigned* p)              { return __hip_atomic_load(p, __ATOMIC_RELAXED, __HIP_MEMORY_SCOPE_AGENT); }
__device__ __forceinline__ unsigned xb_add(unsigned* p, unsigned v) { return __hip_atomic_fetch_add(p, v, __ATOMIC_RELAXED, __HIP_MEMORY_SCOPE_AGENT); }
__device__ __forceinline__ unsigned xb_xcc_id() { return (unsigned)__builtin_amdgcn_s_getreg((3 << 11) | 20) & 0xFu; }
#define XB_SPIN(cond, bar) do { unsigned _sp = 0; while (cond) { __builtin_amdgcn_s_sleep(1); \
    if ((++_sp & 255u) == 0u) { if (xb_ld(&(bar)[XB_TMO])) break; if (_sp > XB_SPIN_CAP) { atomicAdd(&(bar)[XB_TMO], 1u); break; } } } } while (0)

struct XcdBarrier {
    unsigned* bar; unsigned x;
    volatile LAS unsigned* st;
};

__device__ __forceinline__ XcdBarrier xcd_barrier_post(unsigned* bar, volatile LAS unsigned* st) {
    XcdBarrier b; b.bar = bar; b.x = xb_xcc_id(); b.st = st;
    if (threadIdx.x == 0) (void)xb_add(&bar[XB_XCNT(b.x)], 1u);
    return b;
}
__device__ __forceinline__ void xcd_barrier_complete(unsigned* bar, unsigned x, unsigned& nloc, unsigned& nx) {
    const unsigned G = gridDim.x * gridDim.y * gridDim.z;
    unsigned sum, cnt, mine, sp = 0u;
    for (;;) {
        sum = 0u; cnt = 0u; mine = 0u;
#pragma unroll
        for (unsigned j = 0; j < 16; ++j) { const unsigned c = xb_ld(&bar[XB_XCNT(j)]); sum += c; cnt += (c > 0u) ? 1u : 0u; mine = (j == x) ? c : mine; }
        if (sum == G) break;
        __builtin_amdgcn_s_sleep(1);
        if ((++sp & 255u) == 0u) { if (xb_ld(&bar[XB_TMO])) break; if (sp > XB_SPIN_CAP) { atomicAdd(&bar[XB_TMO], 1u); break; } }
    }
    nloc = mine > 0u ? mine : 1u; nx = cnt > 0u ? cnt : 1u;
}

__device__ __forceinline__ void xcd_barrier(const XcdBarrier& b) {
    asm volatile("s_waitcnt vmcnt(0)" ::: "memory");
    __syncthreads();
    if (threadIdx.x == 0) {
        unsigned* bar = b.bar;
        __builtin_amdgcn_s_waitcnt(0);
        unsigned nloc = b.st[0], nx = b.st[1];
        if (nloc == 0u) { xcd_barrier_complete(bar, b.x, nloc, nx); b.st[0] = nloc; b.st[1] = nx; }
        const unsigned old = xb_add(&bar[XB_XSUB(b.x)], 1u);
        const unsigned gen = old / nloc;
        if (old + 1u == (gen + 1u) * nloc) {
            __builtin_amdgcn_fence(__ATOMIC_RELEASE, "agent");
            asm volatile("s_waitcnt vmcnt(0)" ::: "memory");
            const unsigned og = xb_add(&bar[XB_TOP], 1u);
            const unsigned tg = og / nx;
            if (og + 1u == (tg + 1u) * nx) xb_add(&bar[XB_TOPGEN], 1u);
            else XB_SPIN(xb_ld(&bar[XB_TOPGEN]) == tg, bar);
            __builtin_amdgcn_fence(__ATOMIC_ACQUIRE, "agent");
            xb_add(&bar[XB_XGEN(b.x)], 1u);
            asm volatile("s_waitcnt vmcnt(0)" ::: "memory");
        } else {
            XB_SPIN(xb_ld(&bar[XB_XGEN(b.x)]) == gen, bar);
            __builtin_amdgcn_fence(__ATOMIC_ACQUIRE, "agent");
            asm volatile("s_waitcnt vmcnt(0)" ::: "memory");
        }
    }
    __syncthreads();
}

struct EpiFinal {
    static constexpr bool PERM = true, AFTER_DRAIN = true;
    const bf16* base; float* out; float* SSp; const float* g; unsigned* bar; volatile LAS unsigned* st; float alpha;
    __device__ __forceinline__ void fused(pg8::f32x4 (&acc)[2][2][4][2], const pg8::Unit& u, int wr, int wc, int fr, int fq, LAS unsigned char*, int, int) const {
        using pg8::f32x4; constexpr int BM = pg8::BM, HALF = pg8::HALF;
        const int row0 = u.pm * BM + wr * 64 + fr, col0 = u.pn * BM + wc * 32 + 8 * fq;
#pragma unroll
        for (int ai = 0; ai < 2; ++ai) { f32x4 b[4][2][2];
#pragma unroll
            for (int m = 0; m < 4; ++m) { const size_t off = (size_t)(row0 + ai * HALF + m * 16) * 2048 + col0;
#pragma unroll
                for (int bj = 0; bj < 2; ++bj) { const pg8::u32x4 w = __builtin_nontemporal_load((const pg8::u32x4*)(base + pg8::blk(row0 + ai * HALF + m * 16, col0 + bj * HALF, 2048))); b[m][bj][0] = pg8::lo4(w); b[m][bj][1] = pg8::hi4(w); } }
#pragma unroll
            for (int m = 0; m < 4; ++m) { const int row = row0 + ai * HALF + m * 16; float ssq = 0.f;
#pragma unroll
                for (int bj = 0; bj < 2; ++bj) { const f32x4 o0 = b[m][bj][0] + alpha * acc[ai][bj][m][0], o1 = b[m][bj][1] + alpha * acc[ai][bj][m][1];
                    acc[ai][bj][m][0] = o0; acc[ai][bj][m][1] = o1;
                    ssq += ((o0[0] * o0[0] + o0[1] * o0[1]) + (o0[2] * o0[2] + o0[3] * o0[3])) + ((o1[0] * o1[0] + o1[1] * o1[1]) + (o1[2] * o1[2] + o1[3] * o1[3])); }
                ssq += __shfl_xor(ssq, 16); ssq += __shfl_xor(ssq, 32);
                if (fq == 0) SSp[(size_t)row * 32 + u.pn * 4 + wc] = ssq; } }
        { XcdBarrier xb_; xb_.bar = bar; xb_.x = xb_xcc_id(); xb_.st = st; xcd_barrier(xb_); }
        float rsa[2][4];
#pragma unroll
        for (int ai = 0; ai < 2; ++ai)
#pragma unroll
            for (int m = 0; m < 4; ++m) rsa[ai][m] = pg8::row_rscale(SSp, row0 + ai * HALF + m * 16, fq);
        f32x4 gg[2][2];
#pragma unroll
        for (int bj = 0; bj < 2; ++bj) { gg[bj][0] = *(const f32x4*)(g + col0 + bj * HALF); gg[bj][1] = *(const f32x4*)(g + col0 + bj * HALF + 4); }
#pragma unroll
        for (int ai = 0; ai < 2; ++ai)
#pragma unroll
            for (int m = 0; m < 4; ++m) { const size_t off = (size_t)(row0 + ai * HALF + m * 16) * 2048 + col0;
#pragma unroll
                for (int bj = 0; bj < 2; ++bj) { *(f32x4*)(out + off + bj * HALF) = acc[ai][bj][m][0] * rsa[ai][m] * gg[bj][0]; *(f32x4*)(out + off + bj * HALF + 4) = acc[ai][bj][m][1] * rsa[ai][m] * gg[bj][1]; } }
    }
};

constexpr int MIX_SPLIT = 6400;
struct Args { const float* in[28]; float* out; unsigned char* ws; };
enum { I_X = 0, I_MEM, I_F1N, I_F1G, I_F1U, I_F1D, I_MIXN, I_WMIX, I_BG, I_LQ1, I_LK1, I_LQ2, I_LK2, I_SUBLN, I_WA, I_CONVW, I_WC, I_WMO, I_XN, I_MEMN, I_WXQ, I_WXKV, I_WXO, I_F2N, I_F2G, I_F2U, I_F2D, I_FINN };

typedef ab::BlockRef<ab::bf16, ab::bf16> BRef;
__device__ __forceinline__ BRef self_ref(int L, int pass, const bf16* Q, const bf16* K, const bf16* V, bf16* OA, bf16* OB) {
    const int x = L & 3, rest = L >> 2, half = rest & 1, c = (rest >> 1) & 1, h = (rest >> 2) & 7, b = rest >> 5;
    const int qb = pass ? 7 - x : x;
    BRef r; const size_t rb = (size_t)b * SEQ * DM;
    r.Q = (const ab::bf16*)(Q + rb + (size_t)qb * 256 * DM + (h * 2 + c) * 128);
    r.K = (const ab::bf16*)(K + rb + (h * 2 + c) * 128);
    r.V = (const ab::bf16*)(V + rb + h * 256 + half * 128);
    r.O = (ab::bf16*)((c ? OB : OA) + rb + (size_t)qb * 256 * DM + h * 256 + half * 128);
    r.P0 = qb * 256; return r;
}
__device__ __forceinline__ BRef cross_ref(int L, const bf16* XQ, const bf16* XKV, bf16* XO) {
    const int qb = L & 7, hd = (L >> 3) & 3, b = L >> 5;
    BRef r;
    r.Q = (const ab::bf16*)(XQ + ((size_t)b * SEQ + qb * 256) * XW + hd * 128);
    r.K = (const ab::bf16*)(XKV + (size_t)b * MEML * 1024 + hd * 128);
    r.V = (const ab::bf16*)(XKV + (size_t)b * MEML * 1024 + 512 + hd * 128);
    r.O = (ab::bf16*)(XO + ((size_t)b * SEQ + qb * 256) * XW + hd * 128);
    r.P0 = 256; return r;
}

#define P_(name, off) ((bf16*)(ldp(ldsl, 29) + (off)))
#define WMIX P_(0, WS_WMIX)
#define WA P_(0, WS_WA)
#define WC P_(0, WS_WC)
#define WMO P_(0, WS_WMO)
#define WXQ P_(0, WS_WXQ)
#define WXKV P_(0, WS_WXKV)
#define WXO P_(0, WS_WXO)
#define WGU P_(0, WS_WGU)
#define WD P_(0, WS_WD)
#define H P_(0, WS_H)
#define MH P_(0, WS_MH)
#define XKV P_(0, WS_XKV)
#define XQ P_(0, WS_XQ)
#define XO P_(0, WS_XO)
#define Qb P_(0, WS_Q)
#define Kb P_(0, WS_K)
#define Vb P_(0, WS_V)
#define BG P_(0, WS_BG)
#define CU P_(0, WS_CU)
#define GA P_(0, WS_GA)
#define GC P_(0, WS_GC)
#define OA P_(0, WS_OA)
#define OB P_(0, WS_OB)
#define YA P_(0, WS_YA)
#define YC P_(0, WS_YC)
#define MRG P_(0, WS_MRG)
#define ACT P_(0, WS_ACT)
#define T P_(0, WS_T)
#define XB P_(0, WS_XB)
#define SS ((float*)(ldp(ldsl, 29) + WS_SS))
#define X ((float*)ldp(ldsl, 28))
#define IN(i) ((const float*)ldp(ldsl, (i)))
__global__ void __launch_bounds__(NWAVES * 64, 2) mk_fwd(Args a) {
    extern __shared__ __attribute__((aligned(16))) unsigned char lds[];
    LAS unsigned char* ldsl = (LAS unsigned char*)lds;
    if (threadIdx.x < 28) ((LAS unsigned long long*)(ldsl + TAB_OFF))[threadIdx.x] = (unsigned long long)a.in[threadIdx.x];
    if (threadIdx.x == 28) ((LAS unsigned long long*)(ldsl + TAB_OFF))[28] = (unsigned long long)a.out;
    if (threadIdx.x == 29) ((LAS unsigned long long*)(ldsl + TAB_OFF))[29] = (unsigned long long)a.ws;
    if (threadIdx.x == 30) { ((volatile LAS unsigned*)(ldsl + XBST_OFF))[0] = 0u; ((volatile LAS unsigned*)(ldsl + XBST_OFF))[1] = 0u; }
    __syncthreads();
    cg::this_grid().sync();
    XcdBarrier xbar = xcd_barrier_post((unsigned*)a.ws + CW_BAR, (volatile LAS unsigned*)(ldsl + XBST_OFF));
#define GRID_SYNC() do { XcdBarrier xb_; xb_.bar = (unsigned*)ldp(ldsl, 29) + CW_BAR; xb_.x = xb_xcc_id(); xb_.st = (volatile LAS unsigned*)(ldsl + XBST_OFF); xcd_barrier(xb_); } while (0)
    (void)xbar;
    const int G = gridDim.x, bx = blockIdx.x, NGW = G * NWAVES;
#define TL() int tid = threadIdx.x; asm volatile("" : "+v"(tid)); const int lane = tid & 63, wave = __builtin_amdgcn_readfirstlane(tid >> 6), gw = bx * NWAVES + wave; LAS float* scr = (LAS float*)(ldsl + wave * 16640); (void)lane; (void)gw; (void)scr;

    { TL();
    transpose_matrix<1>(IN(I_F1G), DM, DFF, WGU, 0, nullptr, scr, gw, NGW, lane);
    transpose_matrix<1>(IN(I_F1U), DM, DFF, WGU, 128, nullptr, scr, gw, NGW, lane);
    transpose_matrix<0>(IN(I_F1D), DFF, DM, WD, 0, nullptr, scr, gw, NGW, lane);
    transpose_matrix<2>(IN(I_WMIX), DM, NMIX, WMIX, 0, IN(I_MIXN), scr, gw, NGW, lane, 0, MIX_SPLIT);
    transpose_matrix<0>(IN(I_WA), DM, DM, WA, 0, nullptr, scr, gw, NGW, lane);
    transpose_matrix<0>(IN(I_WC), DM, DM, WC, 0, nullptr, scr, gw, NGW, lane);
    transpose_matrix<0>(IN(I_WMO), DM, DM, WMO, 0, nullptr, scr, gw, NGW, lane);
    transpose_matrix<0>(IN(I_WXQ), DM, XW, WXQ, 0, IN(I_XN), scr, gw, NGW, lane);
    transpose_matrix<0>(IN(I_WXKV), DM, 2 * XW, WXKV, 0, nullptr, scr, gw, NGW, lane);
    transpose_matrix<0>(IN(I_WXO), XW, DM, WXO, 0, nullptr, scr, gw, NGW, lane);
    { const float* xi = IN(I_X); const float* gi = IN(I_F1N); bf16* ho = H; for (int m = gw; m < M; m += NGW) rms_row_bf16(xi + (size_t)m * DM, gi, ho, m, lane); }
    { const float* xi = IN(I_MEM); const float* gi = IN(I_MEMN); bf16* ho = MH; for (int m = gw; m < MM; m += NGW) rms_row_bf16(xi + (size_t)m * DM, gi, ho, m, lane); }
    }
    GRID_SYNC();

    { pg8::Gemm g{H, WGU, M, 2 * DFF, DM, 1, 1}; pg8::StaticOrder S; S.init(M, 2 * DFF, G, bx); pg8::EpiSwiglu E{ACT, DFF, nullptr};
      pg8::gemm_phase<pg8::EpiSwiglu, pg8::StaticOrder, true, true>(ldsl, g, S, E); }
    { pg8::Gemm g{MH, WXKV, MM, 2 * XW, DM, 1, 1}; pg8::StaticOrder S; S.init(MM, 2 * XW, G, G - 1 - bx); pg8::EpiBf16<0> E{XKV, 2 * XW, nullptr, 0, 0, 1.f};
      pg8::gemm_phase<pg8::EpiBf16<0>, pg8::StaticOrder, true, true>(ldsl, g, S, E); }
    if (G == 256 ? (bx >= 96 && bx < 240) : (bx == 0)) { TL(); const int nb_ = (G == 256) ? 144 : 1, b0_ = (G == 256) ? 96 : 0;
      transpose_matrix<2>(IN(I_WMIX), DM, NMIX, WMIX, 0, IN(I_MIXN), scr, (bx - b0_) * NWAVES + wave, nb_ * NWAVES, lane, MIX_SPLIT, 0x7fffffff); }
    GRID_SYNC();

    { pg8::Gemm g{ACT, WD, M, DM, DFF, 1, 1}; pg8::StaticOrder S; S.init(M, DM, G, bx); pg8::EpiResidB<true> E{IN(I_X), XB, SS, 0.5f};
      pg8::gemm_phase<pg8::EpiResidB<true>, pg8::StaticOrder, true, true>(ldsl, g, S, E); }
    GRID_SYNC();

    { pg8::Gemm g{XB, WMIX, M, NMIX, DM, 1, 1}; pg8::StaticOrder S; S.init(M, NMIX, G, bx); pg8::EpiMixIn E{Qb, IN(I_BG), SS};
      pg8::gemm_phase<pg8::EpiMixIn, pg8::StaticOrder, true, true>(ldsl, g, S, E); }
    GRID_SYNC();

    {
        constexpr int TOTAL = BATCH * 8 * 2 * 2 * 4;
#ifndef ATT_REP
#define ATT_REP 1
#endif
        for (int rep = 0; rep < ATT_REP; ++rep) {
        int L = bx;
#ifndef NO_SELF
        if (L < TOTAL) {
            const bf16* q_ = Qb; const bf16* k_ = Kb; const bf16* v_ = Vb; bf16* oa_ = OA; bf16* ob_ = OB;
            int pass = 0; BRef cur = self_ref(L, 0, q_, k_, v_, oa_, ob_);
            ab::Seam<ab::bf16> S;
            ab::causal_swa_prime<ab::bf16, ab::bf16, DM, DM, DM>(cur, 1 << 28, (char*)lds, S);
            for (;;) {
                const bool more_pass = pass == 0, more_item = L + G < TOTAL, last = !more_pass && !more_item;
                int passn = pass + 1, Ln = L;
                if (!more_pass) { passn = 0; Ln = more_item ? L + G : L; }
                const BRef nxt = last ? cur : self_ref(Ln, passn, q_, k_, v_, oa_, ob_);
                ab::causal_swa_block<ab::bf16, ab::bf16, DM, DM, DM>(cur, nxt, SEQ, 1 << 28, (char*)lds, S);
                if (last) break;
                cur = nxt; pass = passn; L = Ln;
            }
        }
#endif
        }
    }
    GRID_SYNC();

    {
        TL();
        {
        const float* cw = IN(I_CONVW); const bf16* cu_ = CU; const bf16* bg_ = BG; bf16* yc_ = YC;
        for (int i = bx * (NWAVES * 64) + tid; i < M * (DM / 8); i += G * NWAVES * 64) {
            const int row = i >> 8, c8 = (i & 255) * 8, s = row & (SEQ - 1); const size_t off = (size_t)row * DM + c8;
            const v4u z4 = {0u, 0u, 0u, 0u};
            const v4u u0 = *(const v4u*)(cu_ + off), u1 = s >= 1 ? *(const v4u*)(cu_ + off - DM) : z4, u2 = s >= 2 ? *(const v4u*)(cu_ + off - 2 * DM) : z4, bb = __builtin_nontemporal_load((const v4u*)(bg_ + off));
            const f32x4 w0a = *(const f32x4*)(cw + c8), w0b = *(const f32x4*)(cw + c8 + 4), w1a = *(const f32x4*)(cw + DM + c8), w1b = *(const f32x4*)(cw + DM + c8 + 4), w2a = *(const f32x4*)(cw + 2 * DM + c8), w2b = *(const f32x4*)(cw + 2 * DM + c8 + 4);
            const f32x4 ra = pg8::lo4(bb) * (w0a * pg8::lo4(u2) + w1a * pg8::lo4(u1) + w2a * pg8::lo4(u0));
            const f32x4 rb = pg8::hi4(bb) * (w0b * pg8::hi4(u2) + w1b * pg8::hi4(u1) + w2b * pg8::hi4(u0));
            v4u o; o.x = pk2(ra.x, ra.y); o.y = pk2(ra.z, ra.w); o.z = pk2(rb.x, rb.y); o.w = pk2(rb.z, rb.w);
            *(v4u*)(yc_ + pg8::blk(row, c8, DM)) = o;
        }
            }
        float d1 = IN(I_LQ1)[lane] * IN(I_LK1)[lane] + IN(I_LQ1)[lane + 64] * IN(I_LK1)[lane + 64];
        float d2 = IN(I_LQ2)[lane] * IN(I_LK2)[lane] + IN(I_LQ2)[lane + 64] * IN(I_LK2)[lane + 64];
        const float lam = expf(wave_sum(d1)) - expf(wave_sum(d2)) + LAM_INIT;
        const f32x4 gs = *((const f32x4*)IN(I_SUBLN) + lane) * (1.0f - LAM_INIT);
        const bf16* oa_ = OA; const bf16* ob_ = OB; bf16* ya_ = YA;
        for (int m = gw; m < M; m += NGW) {
            const v2u* pa = (const v2u*)(oa_ + (size_t)m * DM) + lane; const v2u* pb = (const v2u*)(ob_ + (size_t)m * DM) + lane; v2u* po = (v2u*)(ya_ + (size_t)m * DM) + lane;
#pragma unroll
            for (int j = 0; j < 8; ++j) { const v2u wa = __builtin_nontemporal_load(pa + 64 * j), wb = __builtin_nontemporal_load(pb + 64 * j);
                f32x4 d; d.x = __uint_as_float(wa.x << 16) - lam * __uint_as_float(wb.x << 16); d.y = __uint_as_float(wa.x & 0xffff0000u) - lam * __uint_as_float(wb.x & 0xffff0000u);
                d.z = __uint_as_float(wa.y << 16) - lam * __uint_as_float(wb.y << 16); d.w = __uint_as_float(wa.y & 0xffff0000u) - lam * __uint_as_float(wb.y & 0xffff0000u);
                const float ss = wave_sum((d.x * d.x + d.y * d.y) + (d.z * d.z + d.w * d.w));
                const float r = 1.0f / sqrtf(ss * (1.f / 256.f) + SUBLN_EPS);
                const f32x4 o = d * r * gs; v2u w; w.x = pk2(o.x, o.y); w.y = pk2(o.z, o.w); *(v2u*)(ya_ + pg8::blk(m, 4 * lane + 256 * j, DM)) = w; }
        }
    }
    GRID_SYNC();

    { pg8::Gemm g{YA, WA, M, DM, DM, 1, 1}; pg8::StaticOrder S; S.init(M, DM, G, bx); pg8::EpiGateT E{GA, T};
      pg8::gemm_phase<pg8::EpiGateT, pg8::StaticOrder, true, true>(ldsl, g, S, E); }
    { pg8::Gemm g{YC, WC, M, DM, DM, 1, 1}; pg8::StaticOrder S; S.init(M, DM, G, bx); pg8::EpiGateMrg E{GC, T, MRG};
      pg8::gemm_phase<pg8::EpiGateMrg, pg8::StaticOrder, true, true>(ldsl, g, S, E); }
    GRID_SYNC();

    { pg8::Gemm g{MRG, WMO, M, DM, DM, 1, 1}; pg8::StaticOrder S; S.init(M, DM, G, bx); pg8::EpiResidB<false> E{XB, XB, SS, 1.0f};
      pg8::gemm_phase<pg8::EpiResidB<false>, pg8::StaticOrder, true, true>(ldsl, g, S, E); }
    GRID_SYNC();

    if (bx < 64) { pg8::Gemm g{XB, WXQ, M, XW, DM, 1, 1}; pg8::StaticOrder S; S.init(M, XW, 64, bx); pg8::EpiBf16RS E{XQ, XW, SS};
      pg8::gemm_phase<pg8::EpiBf16RS, pg8::StaticOrder, true, true>(ldsl, g, S, E); }
    else { TL(); const int gw2 = (bx - 64) * NWAVES + wave, ngw2 = (G - 64) * NWAVES;
      transpose_matrix<1>(IN(I_F2G), DM, DFF, WGU, 0, IN(I_F2N), scr, gw2, ngw2, lane);
      transpose_matrix<1>(IN(I_F2U), DM, DFF, WGU, 128, IN(I_F2N), scr, gw2, ngw2, lane);
      transpose_matrix<0>(IN(I_F2D), DFF, DM, WD, 0, nullptr, scr, gw2, ngw2, lane); }
    GRID_SYNC();

    {
        constexpr int TOTAL = BATCH * 4 * 8;
        int L = bx;
#ifndef NO_CROSS
        if (L < TOTAL) {
            const bf16* xq_ = XQ; const bf16* xkv_ = XKV; bf16* xo_ = XO;
            BRef cur = cross_ref(L, xq_, xkv_, xo_);
            ab::Seam<ab::bf16> S;
            ab::causal_swa_prime<ab::bf16, ab::bf16, XW, 2 * XW, XW>(cur, 1 << 28, (char*)lds, S);
            for (;;) {
                const bool last = L + G >= TOTAL; const int Ln = last ? L : L + G;
                const BRef nxt = last ? cur : cross_ref(Ln, xq_, xkv_, xo_);
                ab::causal_swa_block<ab::bf16, ab::bf16, XW, 2 * XW, XW>(cur, nxt, MEML, 1 << 28, (char*)lds, S);
                if (last) break;
                cur = nxt; L = Ln;
            }
        }
#endif
    }
    GRID_SYNC();

    { pg8::Gemm g{XO, WXO, M, DM, XW, 0, 1}; pg8::StaticOrder S; S.init(M, DM, G, bx); pg8::EpiResidB<false> E{XB, XB, SS, 1.0f};
      pg8::gemm_phase<pg8::EpiResidB<false>, pg8::StaticOrder, true, true>(ldsl, g, S, E); }
    GRID_SYNC();

    { pg8::Gemm g{XB, WGU, M, 2 * DFF, DM, 1, 1}; pg8::StaticOrder S; S.init(M, 2 * DFF, G, bx); pg8::EpiSwiglu E{ACT, DFF, SS};
      pg8::gemm_phase<pg8::EpiSwiglu, pg8::StaticOrder, true, true>(ldsl, g, S, E); }
    GRID_SYNC();

    if (G == 256) { pg8::Gemm g{ACT, WD, M, DM, DFF, 1, 1}; pg8::StaticOrder S; S.init(M, DM, G, bx);
      EpiFinal E{XB, X, SS, IN(I_FINN), (unsigned*)ldp(ldsl, 29) + CW_BAR, (volatile LAS unsigned*)(ldsl + XBST_OFF), 0.5f};
      pg8::gemm_phase<EpiFinal, pg8::StaticOrder, true, true>(ldsl, g, S, E); }
    else {
      { pg8::Gemm g{ACT, WD, M, DM, DFF, 1, 1}; pg8::StaticOrder S; S.init(M, DM, G, bx); pg8::EpiResidFromB E{XB, X, 0.5f};
        pg8::gemm_phase<pg8::EpiResidFromB, pg8::StaticOrder, true, true>(ldsl, g, S, E); }
      GRID_SYNC();
      { TL(); float* xi = X; const float* gi = IN(I_FINN); for (int m = gw; m < M; m += NGW) rms_row_f32(xi + (size_t)m * DM, gi, xi + (size_t)m * DM, lane); }
    }
}

extern "C" void kernel_launch(void* const* d_in, const int* in_sizes, int n_in, void* d_out, int out_size, void* d_ws, size_t ws_size, hipStream_t stream) {
    static int grid = 0;
    if (grid == 0) {
        if (n_in != 28 || out_size != M * DM || ws_size < WS_END) { fprintf(stderr, "kernel_launch: unexpected shapes (n_in %d out %d ws %zu)\n", n_in, out_size, ws_size); grid = -1; return; }
        int dev = 0, cus = 0, per_cu = 0;
        (void)hipGetDevice(&dev); (void)hipDeviceGetAttribute(&cus, hipDeviceAttributeMultiprocessorCount, dev);
        if (hipFuncSetAttribute((const void*)mk_fwd, hipFuncAttributeMaxDynamicSharedMemorySize, LDS_BYTES) != hipSuccess) { fprintf(stderr, "kernel_launch: hipFuncSetAttribute failed\n"); grid = -1; return; }
        if (hipOccupancyMaxActiveBlocksPerMultiprocessor(&per_cu, (const void*)mk_fwd, NWAVES * 64, LDS_BYTES) != hipSuccess || per_cu < 1) { fprintf(stderr, "kernel_launch: occupancy query says %d\n", per_cu); (void)hipGetLastError(); grid = -1; return; }
        grid = cus * per_cu;
    }
    if (grid < 0) return;
    if (hipMemsetAsync(d_ws, 0, CTL_ZERO_BYTES, stream) != hipSuccess) { fprintf(stderr, "kernel_launch: memset failed\n"); return; }
    Args a{};
    for (int i = 0; i < 28; ++i) a.in[i] = (const float*)d_in[i];
    a.out = (float*)d_out; a.ws = (unsigned char*)d_ws;
    void* args[] = {&a};
    hipError_t e = hipLaunchCooperativeKernel((const void*)mk_fwd, dim3(grid), dim3(NWAVES * 64), args, LDS_BYTES, stream);
    if (e != hipSuccess) fprintf(stderr, "cooperative launch failed: %s (grid %d)\n", hipGetErrorString(e), grid);
}
```

```cpp
#include <hip/hip_runtime.h>
#include <hip/hip_cooperative_groups.h>
#include <hip/hip_bf16.h>
#include <cstdio>
#include <cstdint>
namespace cg = cooperative_groups;
namespace pg8 {
#define PG8_LAS __attribute__((address_space(3)))
typedef unsigned short bf16_t;
typedef short bf16x8 __attribute__((ext_vector_type(8)));
typedef float f32x4 __attribute__((ext_vector_type(4)));
typedef unsigned u32x4 __attribute__((ext_vector_type(4)));
constexpr int BM = 256, BK = 64, HALF = 128, HTB = HALF * BK * 2  , STAGE_BYTES = 8 * HTB, NXCD = 8, WGM = 8;

__host__ __device__ __forceinline__ int lds_byte(int r, int c) { const int st = (r >> 4) * 2 + (c >> 5), rr = r & 15, cc = c & 31, ob = rr * 64 + cc * 2; return st * 1024 + (ob ^ (((ob >> 9) & 1) << 5)); }
__host__ __device__ __forceinline__ void stage_rc(int b, int& R, int& C) { const int st = b / 1024, sb = b % 1024, swz = sb ^ (((sb >> 9) & 1) << 5); R = (st >> 1) * 16 + swz / 64; C = (st & 1) * 32 + (swz % 64) / 2; }
__host__ __device__ __forceinline__ int perm32(int rho) { const int n = rho >> 4, i = rho & 15; return 8 * (i >> 2) + 4 * n + (i & 3); }

struct Unit { int pm, pn; };
struct Gemm { const bf16_t* A; const bf16_t* Bt; int M, N, K, ablk, bblk; };
__host__ __device__ __forceinline__ size_t blk(int row, int col, int K) { return (size_t)(row >> 8) * (size_t)(256 * K) + (size_t)((col >> 6) * 16384 + (row & 255) * 64 + (col & 63)); }

struct StaticOrder {
    int nM, nN, nwg, G, c;
    __host__ __device__ void init(int M, int N, int G_, int c_) { nM = M / BM; nN = N / BM; nwg = nM * nN; G = G_; c = c_; }
    __host__ __device__ bool next(int i, Unit& u) const {
        const long L = (long)i * G + c; if (L >= nwg) return false;
        int wgid = (int)L; { const int q = nwg / NXCD, r = nwg % NXCD, xcd = wgid % NXCD, off = wgid / NXCD; wgid = (xcd < r ? xcd * (q + 1) : r * (q + 1) + (xcd - r) * q) + off; }
        const int nig = WGM * nN, gid = wgid / nig, fm = gid * WGM, gsz = (nM - fm) < WGM ? (nM - fm) : WGM;
        u.pm = fm + ((wgid % nig) % gsz); u.pn = (wgid % nig) / gsz; return true;
    }
    __device__ __forceinline__ void a_ready(const Unit&) const {}
    __device__ __forceinline__ void done(const Unit&) const {}
};

typedef float f32x2_cv __attribute__((ext_vector_type(2))); typedef __bf16 bf16x2_cv __attribute__((ext_vector_type(2)));
__device__ __forceinline__ unsigned cvt_pk_bf16(float lo, float hi) { f32x2_cv v = {lo, hi}; bf16x2_cv b = __builtin_convertvector(v, bf16x2_cv); return __builtin_bit_cast(unsigned, b); }
typedef float f32x2 __attribute__((ext_vector_type(2)));
__device__ __forceinline__ f32x2 gelu_pk(f32x2 v) {
    const f32x2 av = __builtin_elementwise_abs(v), d = av * 0.2316418882f + 1.0f;
    f32x2 t; t.x = __builtin_amdgcn_rcpf(d.x); t.y = __builtin_amdgcn_rcpf(d.y);
    f32x2 q = t * 0.5307027145f + (-0.7265760135f); q = q * t + 0.7107068705f; q = q * t + (-0.142248368f); q = q * t + 0.127414796f; q = q * t;
    const f32x2 s = (v * v) * (-0.72134752044f);
    f32x2 e; e.x = __builtin_amdgcn_exp2f(s.x); e.y = __builtin_amdgcn_exp2f(s.y);
    const f32x2 m = v * (q * e), r = v - m;
    f32x2 o; o.x = v.x < 0.f ? m.x : r.x; o.y = v.y < 0.f ? m.y : r.y; return o;
}

template <int ACT  > struct EpiBf16 {
    static constexpr bool PERM = true, AFTER_DRAIN = false; static_assert(ACT == 0 || ACT == 1, "EpiBf16: ACT is 0 (none) or 1 (gelu_pk)");
    bf16_t* O; int ldc; const float* bias; int split_cols; size_t split_stride; float scale0;
    __device__ __forceinline__ void operator()(const f32x4 (&acc)[2][2][4][2], const Unit& u, int wr, int wc, int fr, int fq) const {
        const int row0 = u.pm * BM + wr * 64 + fr; int colt = u.pn * BM; bf16_t* base = O;
        float sc = 1.f; if (split_cols) { const int t = colt / split_cols; base += (size_t)t * split_stride; colt -= t * split_cols; if (t == 0) sc = scale0; }
        const int col0 = colt + wc * 32 + 8 * fq, bcol0 = u.pn * BM + wc * 32 + 8 * fq;
        f32x4 bv[2][2];
#pragma unroll
        for (int bj = 0; bj < 2; ++bj)
#pragma unroll
            for (int n = 0; n < 2; ++n) bv[bj][n] = bias ? *(const f32x4*)(bias + bcol0 + bj * HALF + 4 * n) : (f32x4){0.f, 0.f, 0.f, 0.f};
#pragma unroll
        for (int ai = 0; ai < 2; ++ai)
#pragma unroll
            for (int m = 0; m < 4; ++m) { bf16_t* rowp = base + (size_t)(row0 + ai * HALF + m * 16) * ldc + col0;
#pragma unroll
                for (int bj = 0; bj < 2; ++bj) { f32x4 v0 = acc[ai][bj][m][0] + bv[bj][0], v1 = acc[ai][bj][m][1] + bv[bj][1];
                    if (ACT == 1) { f32x2 a = gelu_pk((f32x2){v0[0], v0[1]}), b = gelu_pk((f32x2){v0[2], v0[3]}), c = gelu_pk((f32x2){v1[0], v1[1]}), d = gelu_pk((f32x2){v1[2], v1[3]});
                        v0 = (f32x4){a.x, a.y, b.x, b.y}; v1 = (f32x4){c.x, c.y, d.x, d.y}; }
                    v0 = v0 * sc; v1 = v1 * sc; u32x4 w; w.x = cvt_pk_bf16(v0[0], v0[1]); w.y = cvt_pk_bf16(v0[2], v0[3]); w.z = cvt_pk_bf16(v1[0], v1[1]); w.w = cvt_pk_bf16(v1[2], v1[3]);
                    *(u32x4*)(rowp + bj * HALF) = w; } }
    }
};

__device__ __forceinline__ float bf2f(unsigned short b) { return __uint_as_float(((unsigned)b) << 16); }
__device__ __forceinline__ float sigmoidf_(float v) { return __builtin_amdgcn_rcpf(1.0f + __builtin_amdgcn_exp2f(-1.4426950408889634f * v)); }
__device__ __forceinline__ f32x4 lo4(u32x4 w) { return (f32x4){__uint_as_float(w.x << 16), __uint_as_float(w.x & 0xffff0000u), __uint_as_float(w.y << 16), __uint_as_float(w.y & 0xffff0000u)}; }
__device__ __forceinline__ f32x4 hi4(u32x4 w) { return (f32x4){__uint_as_float(w.z << 16), __uint_as_float(w.z & 0xffff0000u), __uint_as_float(w.w << 16), __uint_as_float(w.w & 0xffff0000u)}; }
__device__ __forceinline__ u32x4 pack8f(f32x4 a, f32x4 b) { u32x4 w; w.x = cvt_pk_bf16(a[0], a[1]); w.y = cvt_pk_bf16(a[2], a[3]); w.z = cvt_pk_bf16(b[0], b[1]); w.w = cvt_pk_bf16(b[2], b[3]); return w; }

__device__ __forceinline__ float row_rscale(const float* SS, int row, int fq) {
    const f32x4 a = *(const f32x4*)(SS + (size_t)row * 32 + fq * 8), b = *(const f32x4*)(SS + (size_t)row * 32 + fq * 8 + 4);
    float s = ((a[0] + a[1]) + (a[2] + a[3])) + ((b[0] + b[1]) + (b[2] + b[3]));
    s += __shfl_xor(s, 16); s += __shfl_xor(s, 32);
    return 1.0f / sqrtf(s * (1.f / 2048.f) + 1e-6f);
}
struct EpiSwiglu {
    static constexpr bool PERM = true, AFTER_DRAIN = false;
    bf16_t* O; int ldc; const float* SS;
    __device__ __forceinline__ void operator()(const f32x4 (&acc)[2][2][4][2], const Unit& u, int wr, int wc, int fr, int fq) const {
        const int row0 = u.pm * BM + wr * 64 + fr, col0 = u.pn * HALF + wc * 32 + 8 * fq;
        float rsa[2][4];
#pragma unroll
        for (int ai = 0; ai < 2; ++ai)
#pragma unroll
            for (int m = 0; m < 4; ++m) rsa[ai][m] = SS ? row_rscale(SS, row0 + ai * HALF + m * 16, fq) : 1.f;
#pragma unroll
        for (int ai = 0; ai < 2; ++ai)
#pragma unroll
            for (int m = 0; m < 4; ++m) { bf16_t* rowp = O + blk(row0 + ai * HALF + m * 16, col0, ldc);
                const float rs = rsa[ai][m];
                f32x4 v[2];
#pragma unroll
                for (int n = 0; n < 2; ++n) { const f32x4 g = acc[ai][0][m][n] * rs, up = acc[ai][1][m][n] * rs;
#pragma unroll
                    for (int j = 0; j < 4; ++j) v[n][j] = g[j] * sigmoidf_(g[j]) * up[j]; }
                *(u32x4*)rowp = pack8f(v[0], v[1]); }
    }
};
struct EpiResid {
    static constexpr bool PERM = true, AFTER_DRAIN = false;
    const float* base; float* out; int ldc; float alpha;
    __device__ __forceinline__ void operator()(const f32x4 (&acc)[2][2][4][2], const Unit& u, int wr, int wc, int fr, int fq) const {
        const int row0 = u.pm * BM + wr * 64 + fr, col0 = u.pn * BM + wc * 32 + 8 * fq;
#pragma unroll
        for (int ai = 0; ai < 2; ++ai) { f32x4 b[4][2][2];
#pragma unroll
            for (int m = 0; m < 4; ++m) { const size_t off = (size_t)(row0 + ai * HALF + m * 16) * ldc + col0;
#pragma unroll
                for (int bj = 0; bj < 2; ++bj) { b[m][bj][0] = *(const f32x4*)(base + off + bj * HALF); b[m][bj][1] = *(const f32x4*)(base + off + bj * HALF + 4); } }
#pragma unroll
            for (int m = 0; m < 4; ++m) { const size_t off = (size_t)(row0 + ai * HALF + m * 16) * ldc + col0;
#pragma unroll
                for (int bj = 0; bj < 2; ++bj) { *(f32x4*)(out + off + bj * HALF) = b[m][bj][0] + alpha * acc[ai][bj][m][0]; *(f32x4*)(out + off + bj * HALF + 4) = b[m][bj][1] + alpha * acc[ai][bj][m][1]; } } }
    }
};
struct EpiResidN {
    static constexpr bool PERM = true, AFTER_DRAIN = false;
    const float* base; float* out; bf16_t* XB; float* SS; float alpha;
    __device__ __forceinline__ void operator()(const f32x4 (&acc)[2][2][4][2], const Unit& u, int wr, int wc, int fr, int fq) const {
        const int row0 = u.pm * BM + wr * 64 + fr, col0 = u.pn * BM + wc * 32 + 8 * fq;
#pragma unroll
        for (int ai = 0; ai < 2; ++ai) { f32x4 b[4][2][2];
#pragma unroll
            for (int m = 0; m < 4; ++m) { const size_t off = (size_t)(row0 + ai * HALF + m * 16) * 2048 + col0;
#pragma unroll
                for (int bj = 0; bj < 2; ++bj) { b[m][bj][0] = *(const f32x4*)(base + off + bj * HALF); b[m][bj][1] = *(const f32x4*)(base + off + bj * HALF + 4); } }
#pragma unroll
            for (int m = 0; m < 4; ++m) { const int row = row0 + ai * HALF + m * 16; const size_t off = (size_t)row * 2048 + col0; float ssq = 0.f;
#pragma unroll
                for (int bj = 0; bj < 2; ++bj) { const f32x4 o0 = b[m][bj][0] + alpha * acc[ai][bj][m][0], o1 = b[m][bj][1] + alpha * acc[ai][bj][m][1];
                    *(f32x4*)(out + off + bj * HALF) = o0; *(f32x4*)(out + off + bj * HALF + 4) = o1;
                    *(u32x4*)(XB + off + bj * HALF) = pack8f(o0, o1);
                    ssq += ((o0[0] * o0[0] + o0[1] * o0[1]) + (o0[2] * o0[2] + o0[3] * o0[3])) + ((o1[0] * o1[0] + o1[1] * o1[1]) + (o1[2] * o1[2] + o1[3] * o1[3])); }
                ssq += __shfl_xor(ssq, 16); ssq += __shfl_xor(ssq, 32);
                if (fq == 0) SS[(size_t)row * 32 + u.pn * 4 + wc] = ssq; } }
    }
};
template <bool BASE_F32> struct EpiResidB {
    static constexpr bool PERM = true, AFTER_DRAIN = false;
    const void* base; bf16_t* XB; float* SS; float alpha;
    __device__ __forceinline__ void operator()(const f32x4 (&acc)[2][2][4][2], const Unit& u, int wr, int wc, int fr, int fq) const {
        const int row0 = u.pm * BM + wr * 64 + fr, col0 = u.pn * BM + wc * 32 + 8 * fq;
#pragma unroll
        for (int ai = 0; ai < 2; ++ai) { f32x4 b[4][2][2];
#pragma unroll
            for (int m = 0; m < 4; ++m) { const size_t off = (size_t)(row0 + ai * HALF + m * 16) * 2048 + col0;
#pragma unroll
                for (int bj = 0; bj < 2; ++bj) {
                    if constexpr (BASE_F32) { b[m][bj][0] = __builtin_nontemporal_load((const f32x4*)((const float*)base + off + bj * HALF)); b[m][bj][1] = __builtin_nontemporal_load((const f32x4*)((const float*)base + off + bj * HALF + 4)); }
                    else { const u32x4 w = __builtin_nontemporal_load((const u32x4*)((const bf16_t*)base + blk(row0 + ai * HALF + m * 16, col0 + bj * HALF, 2048))); b[m][bj][0] = lo4(w); b[m][bj][1] = hi4(w); } } }
#pragma unroll
            for (int m = 0; m < 4; ++m) { const int row = row0 + ai * HALF + m * 16; const size_t off = (size_t)row * 2048 + col0; float ssq = 0.f;
#pragma unroll
                for (int bj = 0; bj < 2; ++bj) { const f32x4 o0 = b[m][bj][0] + alpha * acc[ai][bj][m][0], o1 = b[m][bj][1] + alpha * acc[ai][bj][m][1];
                    *(u32x4*)(XB + blk(row, col0 + bj * HALF, 2048)) = pack8f(o0, o1);
                    ssq += ((o0[0] * o0[0] + o0[1] * o0[1]) + (o0[2] * o0[2] + o0[3] * o0[3])) + ((o1[0] * o1[0] + o1[1] * o1[1]) + (o1[2] * o1[2] + o1[3] * o1[3])); }
                ssq += __shfl_xor(ssq, 16); ssq += __shfl_xor(ssq, 32);
                if (fq == 0) SS[(size_t)row * 32 + u.pn * 4 + wc] = ssq; } }
    }
};
struct EpiResidFromB {
    static constexpr bool PERM = true, AFTER_DRAIN = false;
    const bf16_t* XB; float* out; float alpha;
    __device__ __forceinline__ void operator()(const f32x4 (&acc)[2][2][4][2], const Unit& u, int wr, int wc, int fr, int fq) const {
        const int row0 = u.pm * BM + wr * 64 + fr, col0 = u.pn * BM + wc * 32 + 8 * fq;
#pragma unroll
        for (int ai = 0; ai < 2; ++ai)
#pragma unroll
            for (int m = 0; m < 4; ++m) { const size_t off = (size_t)(row0 + ai * HALF + m * 16) * 2048 + col0;
#pragma unroll
                for (int bj = 0; bj < 2; ++bj) { const u32x4 w = *(const u32x4*)(XB + blk(row0 + ai * HALF + m * 16, col0 + bj * HALF, 2048));
                    *(f32x4*)(out + off + bj * HALF) = lo4(w) + alpha * acc[ai][bj][m][0]; *(f32x4*)(out + off + bj * HALF + 4) = hi4(w) + alpha * acc[ai][bj][m][1]; } }
    }
};
struct EpiBf16RS {
    static constexpr bool PERM = true, AFTER_DRAIN = false;
    bf16_t* O; int ldc; const float* SS;
    __device__ __forceinline__ void operator()(const f32x4 (&acc)[2][2][4][2], const Unit& u, int wr, int wc, int fr, int fq) const {
        const int row0 = u.pm * BM + wr * 64 + fr, col0 = u.pn * BM + wc * 32 + 8 * fq;
        float rsa[2][4];
#pragma unroll
        for (int ai = 0; ai < 2; ++ai)
#pragma unroll
            for (int m = 0; m < 4; ++m) rsa[ai][m] = row_rscale(SS, row0 + ai * HALF + m * 16, fq);
#pragma unroll
        for (int ai = 0; ai < 2; ++ai)
#pragma unroll
            for (int m = 0; m < 4; ++m) { const int row = row0 + ai * HALF + m * 16; const float rs = rsa[ai][m];
#pragma unroll
                for (int bj = 0; bj < 2; ++bj) *(u32x4*)(O + (size_t)row * ldc + col0 + bj * HALF) = pack8f(acc[ai][bj][m][0] * rs, acc[ai][bj][m][1] * rs); }
    }
};
struct EpiMixIn {
    static constexpr bool PERM = true, AFTER_DRAIN = false;
    bf16_t* base; const float* bg; const float* SS;
    __device__ __forceinline__ void operator()(const f32x4 (&acc)[2][2][4][2], const Unit& u, int wr, int wc, int fr, int fq) const {
        const int seg = u.pn >> 3, row0 = u.pm * BM + wr * 64 + fr; constexpr size_t RS = (size_t)8192 * 2048;
        bf16_t* CU = base + 4 * RS;
        float rs[2][4];
#pragma unroll
        for (int ai = 0; ai < 2; ++ai)
#pragma unroll
            for (int m = 0; m < 4; ++m) rs[ai][m] = row_rscale(SS, row0 + ai * HALF + m * 16, fq);
        if (seg == 4 || seg == 5) {
            const int col0 = (u.pn - 32) * HALF + wc * 32 + 8 * fq;
#pragma unroll
            for (int ai = 0; ai < 2; ++ai)
#pragma unroll
                for (int m = 0; m < 4; ++m) *(u32x4*)(CU + (size_t)(row0 + ai * HALF + m * 16) * 2048 + col0) = pack8f(acc[ai][0][m][0] * acc[ai][1][m][0] * (rs[ai][m] * rs[ai][m]), acc[ai][0][m][1] * acc[ai][1][m][1] * (rs[ai][m] * rs[ai][m]));
        } else if (seg >= 6) {
            bf16_t* dst = base + (size_t)(seg - 1) * RS; const int col0 = (u.pn & 7) * BM + wc * 32 + 8 * fq; const float* bb = bg + (seg - 6) * 2048 + col0;
#pragma unroll
            for (int bj = 0; bj < 2; ++bj) { const f32x4 b0 = *(const f32x4*)(bb + bj * HALF), b1 = *(const f32x4*)(bb + bj * HALF + 4);
#pragma unroll
                for (int ai = 0; ai < 2; ++ai)
#pragma unroll
                    for (int m = 0; m < 4; ++m) { f32x4 v0 = acc[ai][bj][m][0] * rs[ai][m] + b0, v1 = acc[ai][bj][m][1] * rs[ai][m] + b1;
#pragma unroll
                        for (int j = 0; j < 4; ++j) { v0[j] = sigmoidf_(v0[j]); v1[j] = sigmoidf_(v1[j]); }
                        *(u32x4*)(dst + (size_t)(row0 + ai * HALF + m * 16) * 2048 + col0 + bj * HALF) = pack8f(v0, v1); } }
        } else {
            bf16_t* dst = base + (size_t)seg * RS; const int col0 = (u.pn & 7) * BM + wc * 32 + 8 * fq;
#pragma unroll
            for (int ai = 0; ai < 2; ++ai)
#pragma unroll
                for (int m = 0; m < 4; ++m)
#pragma unroll
                    for (int bj = 0; bj < 2; ++bj) *(u32x4*)(dst + (size_t)(row0 + ai * HALF + m * 16) * 2048 + col0 + bj * HALF) = pack8f(acc[ai][bj][m][0] * rs[ai][m], acc[ai][bj][m][1] * rs[ai][m]);
        }
    }
};
struct EpiGateT {
    static constexpr bool PERM = true, AFTER_DRAIN = false;
    const bf16_t* G; bf16_t* T;
    __device__ __forceinline__ void operator()(const f32x4 (&acc)[2][2][4][2], const Unit& u, int wr, int wc, int fr, int fq) const {
        const int row0 = u.pm * BM + wr * 64 + fr, col0 = u.pn * BM + wc * 32 + 8 * fq;
#pragma unroll
        for (int ai = 0; ai < 2; ++ai) { u32x4 g[4][2];
#pragma unroll
            for (int m = 0; m < 4; ++m)
#pragma unroll
                for (int bj = 0; bj < 2; ++bj) g[m][bj] = __builtin_nontemporal_load((const u32x4*)(G + (size_t)(row0 + ai * HALF + m * 16) * 2048 + col0 + bj * HALF));
#pragma unroll
            for (int m = 0; m < 4; ++m)
#pragma unroll
                for (int bj = 0; bj < 2; ++bj) *(u32x4*)(T + (size_t)(row0 + ai * HALF + m * 16) * 2048 + col0 + bj * HALF) = pack8f(lo4(g[m][bj]) * acc[ai][bj][m][0], hi4(g[m][bj]) * acc[ai][bj][m][1]); }
    }
};
struct EpiGateMrg {
    static constexpr bool PERM = true, AFTER_DRAIN = false;
    const bf16_t* G; const bf16_t* T; bf16_t* O;
    __device__ __forceinline__ void operator()(const f32x4 (&acc)[2][2][4][2], const Unit& u, int wr, int wc, int fr, int fq) const {
        const int row0 = u.pm * BM + wr * 64 + fr, col0 = u.pn * BM + wc * 32 + 8 * fq;
#pragma unroll
        for (int ai = 0; ai < 2; ++ai) { u32x4 g[4][2], t[4][2];
#pragma unroll
            for (int m = 0; m < 4; ++m)
#pragma unroll
                for (int bj = 0; bj < 2; ++bj) { const size_t off = (size_t)(row0 + ai * HALF + m * 16) * 2048 + col0 + bj * HALF; g[m][bj] = __builtin_nontemporal_load((const u32x4*)(G + off)); t[m][bj] = __builtin_nontemporal_load((const u32x4*)(T + off)); }
#pragma unroll
            for (int m = 0; m < 4; ++m)
#pragma unroll
                for (int bj = 0; bj < 2; ++bj) *(u32x4*)(O + blk(row0 + ai * HALF + m * 16, col0 + bj * HALF, 2048)) = pack8f(lo4(t[m][bj]) + lo4(g[m][bj]) * acc[ai][bj][m][0], hi4(t[m][bj]) + hi4(g[m][bj]) * acc[ai][bj][m][1]); }
    }
};

template <class Epi, class Sched, bool ALIGN_EPI = false, bool SP2 = false>
__device__ __forceinline__ void gemm_phase(PG8_LAS unsigned char* lds, const Gemm g, const Sched& S, const Epi& E) {
    int tid_ = threadIdx.x; asm volatile("" : "+v"(tid_));
    const int tid = tid_, wid = __builtin_amdgcn_readfirstlane(tid >> 6), lane = tid & 63, wr = wid >> 2, wc = wid & 3, fr = lane & 15, fq = lane >> 4;
    const int K = g.K, nt = K / BK;
    unsigned voffA[2], voffB[2];
#pragma unroll
    for (int i = 0; i < 2; ++i) { int R, C; stage_rc(tid * 16 + i * 8192, R, C); const int Rb = Epi::PERM ? ((R & ~31) + perm32(R & 31)) : R;
        voffA[i] = (unsigned)(g.ablk ? (R * 64 + C) : (R * K + C)) * 2u; voffB[i] = (unsigned)(g.bblk ? (Rb * 64 + C) : (Rb * K + C)) * 2u; }
    const size_t kstepA = g.ablk ? (size_t)(BM * BK * 2) : (size_t)(BK * 2), kstepB = g.bblk ? (size_t)(BM * BK * 2) : (size_t)(BK * 2);
    const size_t hstepA = g.ablk ? (size_t)(HALF * BK * 2) : (size_t)HALF * K * 2, hstepB = g.bblk ? (size_t)(HALF * BK * 2) : (size_t)HALF * K * 2;
    const size_t tstep = (size_t)BM * K * 2;
    const unsigned ldsw = (unsigned)wid * 1024u;
    const int aoff = lds_byte(wr * 64 + fr, fq * 8), boff = lds_byte(wc * 32 + fr, fq * 8);
#define PG8_SA(b, h) (((b) * 2 + (h)) * HTB)
#define PG8_SB(b, h) ((4 + (b) * 2 + (h)) * HTB)
#define PG8_STAGE(bufoff, gbase, voff) do { _Pragma("unroll") for (int _i = 0; _i < 2; ++_i) \
        __builtin_amdgcn_global_load_lds((const unsigned*)((const char*)(gbase) + (voff)[_i]), (PG8_LAS unsigned*)(lds + (bufoff) + ldsw + _i * 8192), 16, 0, 0); } while (0)
#define PG8_LDA(dst, b, h) do { _Pragma("unroll") for (int m = 0; m < 4; ++m) _Pragma("unroll") for (int k = 0; k < 2; ++k) dst[m][k] = *(const PG8_LAS bf16x8*)(lds + PG8_SA(b, h) + aoff + m * 2048 + k * 1024); } while (0)
#define PG8_LDB(dst, b, h) do { _Pragma("unroll") for (int n = 0; n < 2; ++n) _Pragma("unroll") for (int k = 0; k < 2; ++k) dst[n][k] = *(const PG8_LAS bf16x8*)(lds + PG8_SB(b, h) + boff + n * 2048 + k * 1024); } while (0)
#define PG8_MMA(ai, bj, At, Bt) do { __builtin_amdgcn_s_setprio(1); _Pragma("unroll") for (int m = 0; m < 4; ++m) _Pragma("unroll") for (int n = 0; n < 2; ++n) _Pragma("unroll") for (int k = 0; k < 2; ++k) \
        acc[ai][bj][m][n] = __builtin_amdgcn_mfma_f32_16x16x32_bf16(Bt[n][k], At[m][k], acc[ai][bj][m][n], 0, 0, 0); __builtin_amdgcn_s_setprio(0); } while (0)
#define PG8_WAIT_V(n) asm volatile("s_waitcnt vmcnt(" #n ")" ::: "memory")
#define PG8_WAIT_L(n) asm volatile("s_waitcnt lgkmcnt(" #n ")" ::: "memory")
#define PG8_BAR __builtin_amdgcn_s_barrier()
#define PG8_SCHED __builtin_amdgcn_sched_barrier(0)
    Unit cur, nxt; int ui = 0;
    if (!S.next(0, cur)) return;
    f32x4 acc[2][2][4][2];
#pragma unroll
    for (int a = 0; a < 2; ++a)
#pragma unroll
        for (int b = 0; b < 2; ++b)
#pragma unroll
            for (int m = 0; m < 4; ++m)
#pragma unroll
                for (int n = 0; n < 2; ++n) acc[a][b][m][n] = (f32x4){0.f, 0.f, 0.f, 0.f};
    bf16x8 At[4][2], B0[2][2], B1[2][2];
    const char* cA = (const char*)g.A + (size_t)cur.pm * tstep; const char* cB = (const char*)g.Bt + (size_t)cur.pn * tstep;
    S.a_ready(cur);
    if constexpr (SP2) {
        PG8_STAGE(PG8_SB(0, 0), cB, voffB); PG8_STAGE(PG8_SB(0, 1), cB + hstepB, voffB); PG8_STAGE(PG8_SA(0, 0), cA, voffA); PG8_STAGE(PG8_SA(0, 1), cA + hstepA, voffA);
        if (wr == 1) PG8_BAR;
        PG8_WAIT_V(2); PG8_BAR;
        PG8_STAGE(PG8_SB(1, 0), cB + kstepB, voffB); PG8_STAGE(PG8_SA(1, 0), cA + kstepA, voffA); PG8_STAGE(PG8_SB(1, 1), cB + hstepB + kstepB, voffB);
        PG8_WAIT_V(6); PG8_BAR;
    } else {
        PG8_STAGE(PG8_SB(0, 0), cB, voffB); PG8_STAGE(PG8_SA(0, 0), cA, voffA); PG8_STAGE(PG8_SB(0, 1), cB + hstepB, voffB); PG8_STAGE(PG8_SA(0, 1), cA + hstepA, voffA);
        if (wr == 1) PG8_BAR;
        PG8_WAIT_V(4); PG8_BAR;
        PG8_STAGE(PG8_SB(1, 0), cB + kstepB, voffB); PG8_STAGE(PG8_SA(1, 0), cA + kstepA, voffA); PG8_STAGE(PG8_SB(1, 1), cB + hstepB + kstepB, voffB);
        PG8_WAIT_V(6); PG8_BAR;
    }
    for (;;) {
        const bool has_next = S.next(ui + 1, nxt);
        const char* nA = has_next ? (const char*)g.A + (size_t)nxt.pm * tstep : cA; const char* nB = has_next ? (const char*)g.Bt + (size_t)nxt.pn * tstep : cB;
        for (int t = 0; t < nt; t += 2) {
            const bool last = (t == nt - 2);
            const char* a1 = cA + (size_t)(t + 1) * kstepA;
            const char* a2 = last ? nA : cA + (size_t)(t + 2) * kstepA; const char* b2 = last ? nB : cB + (size_t)(t + 2) * kstepB;
            const char* a3 = a2 + kstepA; const char* b3 = b2 + kstepB;
            if (last && has_next) S.a_ready(nxt);
            if constexpr (SP2) {
            PG8_LDB(B0, 0, 0); PG8_LDB(B1, 0, 1); PG8_SCHED; PG8_LDA(At, 0, 0); PG8_STAGE(PG8_SA(1, 1), a1 + hstepA, voffA);
            PG8_WAIT_V(8); PG8_WAIT_L(0); PG8_BAR; PG8_MMA(0, 0, At, B0); PG8_MMA(0, 1, At, B1); PG8_BAR; PG8_SCHED;
            PG8_LDA(At, 0, 1); PG8_STAGE(PG8_SB(0, 0), b2, voffB); PG8_STAGE(PG8_SB(0, 1), b2 + hstepB, voffB); PG8_STAGE(PG8_SA(0, 0), a2, voffA);
            PG8_WAIT_V(8); PG8_WAIT_L(0); PG8_BAR; PG8_MMA(1, 0, At, B0); PG8_MMA(1, 1, At, B1); PG8_BAR; PG8_SCHED;
            PG8_LDB(B0, 1, 0); PG8_LDB(B1, 1, 1); PG8_SCHED; PG8_LDA(At, 1, 0); PG8_STAGE(PG8_SA(0, 1), a2 + hstepA, voffA);
            PG8_WAIT_V(8); PG8_WAIT_L(0); PG8_BAR; PG8_MMA(0, 0, At, B0); PG8_MMA(0, 1, At, B1); PG8_BAR; PG8_SCHED;
            PG8_LDA(At, 1, 1); PG8_STAGE(PG8_SB(1, 0), b3, voffB); PG8_STAGE(PG8_SB(1, 1), b3 + hstepB, voffB); PG8_STAGE(PG8_SA(1, 0), a3, voffA);
            PG8_WAIT_V(8); PG8_WAIT_L(0); PG8_BAR; PG8_MMA(1, 0, At, B0); PG8_MMA(1, 1, At, B1); PG8_BAR; PG8_SCHED;
            } else {
            PG8_LDB(B0, 0, 0); PG8_SCHED; PG8_LDA(At, 0, 0); PG8_STAGE(PG8_SA(1, 1), a1 + hstepA, voffA);
            PG8_WAIT_L(8); PG8_BAR; PG8_WAIT_L(0); PG8_MMA(0, 0, At, B0); PG8_BAR; PG8_SCHED;
            PG8_LDB(B1, 0, 1); PG8_STAGE(PG8_SB(0, 0), b2, voffB);
            PG8_BAR; PG8_WAIT_L(0); PG8_MMA(0, 1, At, B1); PG8_BAR;
            PG8_LDA(At, 0, 1); PG8_STAGE(PG8_SA(0, 0), a2, voffA);
            PG8_BAR; PG8_WAIT_L(0); PG8_MMA(1, 0, At, B0); PG8_BAR; PG8_SCHED;
            PG8_STAGE(PG8_SB(0, 1), b2 + hstepB, voffB);
            PG8_WAIT_V(6); PG8_BAR; PG8_MMA(1, 1, At, B1); PG8_BAR;
            PG8_LDB(B0, 1, 0); PG8_SCHED; PG8_LDA(At, 1, 0); PG8_STAGE(PG8_SA(0, 1), a2 + hstepA, voffA);
            PG8_WAIT_L(8); PG8_BAR; PG8_WAIT_L(0); PG8_MMA(0, 0, At, B0); PG8_BAR; PG8_SCHED;
            PG8_LDB(B1, 1, 1); PG8_STAGE(PG8_SB(1, 0), b3, voffB);
            PG8_BAR; PG8_WAIT_L(0); PG8_MMA(0, 1, At, B1); PG8_BAR;
            PG8_LDA(At, 1, 1); PG8_STAGE(PG8_SA(1, 0), a3, voffA);
            PG8_BAR; PG8_WAIT_L(0); PG8_MMA(1, 0, At, B0); PG8_BAR; PG8_SCHED;
            PG8_STAGE(PG8_SB(1, 1), b3 + hstepB, voffB);
            PG8_WAIT_V(6); PG8_BAR; PG8_MMA(1, 1, At, B1); PG8_BAR;
            }
        }
        if constexpr (ALIGN_EPI) { if (wr == 0) PG8_BAR; }
        if constexpr (!Epi::AFTER_DRAIN) { E(acc, cur, wr, wc, fr, fq); S.done(cur); }
        if (!has_next) break;
#pragma unroll
        for (int a = 0; a < 2; ++a)
#pragma unroll
            for (int b = 0; b < 2; ++b)
#pragma unroll
                for (int m = 0; m < 4; ++m)
#pragma unroll
                    for (int n = 0; n < 2; ++n) acc[a][b][m][n] = (f32x4){0.f, 0.f, 0.f, 0.f};
        cur = nxt; cA = nA; cB = nB; ++ui;
        if constexpr (ALIGN_EPI) { if (wr == 1) PG8_BAR; }
    }
    PG8_WAIT_V(0);
    if constexpr (!ALIGN_EPI) { if (wr == 0) PG8_BAR; }
    PG8_BAR;
    if constexpr (Epi::AFTER_DRAIN) { E.fused(acc, cur, wr, wc, fr, fq, lds, wid, lane); S.done(cur); }
#undef PG8_SA
#undef PG8_SB
#undef PG8_STAGE
#undef PG8_LDA
#undef PG8_LDB
#undef PG8_MMA
#undef PG8_WAIT_V
#undef PG8_WAIT_L
#undef PG8_BAR
#undef PG8_SCHED
}
}
namespace ab {
constexpr int D = 128;
constexpr float THR = 8.f;
constexpr bool WSKIP = false;
constexpr float SCALE = 0.08838834764831845f;
constexpr int NW = 8, QBLK = 32, KVBLK = 64, QB = NW * QBLK;
constexpr int SHM_V = KVBLK * D * 2, SHM_K = KVBLK * D * 2;
constexpr int LDS_BYTES = 2 * SHM_V + 2 * SHM_K + NW * 64 * 4;
using bf16 = __hip_bfloat16;
typedef short bf16x8 __attribute__((ext_vector_type(8)));
typedef short s16x4 __attribute__((ext_vector_type(4)));
typedef float f32x16 __attribute__((ext_vector_type(16)));
typedef float f32x4 __attribute__((ext_vector_type(4)));
typedef unsigned u32x4 __attribute__((ext_vector_type(4)));
template <class A, class Bt> struct same_t { static constexpr bool v = false; };
template <class A> struct same_t<A, A> { static constexpr bool v = true; };
#define KSWZ(row, colB) ((row) * 256 + ((colB) ^ (((row) & 7) << 4)))
#define SBAR() __builtin_amdgcn_sched_barrier(0)
__device__ __forceinline__ int v_st(int k, int c) { const int kk = (k & ~0xC) | ((k & 4) << 1) | ((k & 8) >> 1); return ((kk >> 3) * 4 + (c >> 5)) * 512 + ((kk & 7) * 32 + (c & 31)) * 2; }
__device__ __forceinline__ int v_rd_base(int lane) { return ((lane & 3) << 3) | (((lane >> 2) & 3) << 6) | (((lane >> 4) & 1) << 5) | (((lane >> 5) & 1) << 8); }
constexpr int v_rd_off(int d0, int ks, int half) { return d0 * 512 + ks * 4096 + half * 2048; }
__device__ __forceinline__ int crow(int r, int hi) { return (r & 3) + 8 * (r >> 2) + 4 * hi; }
__device__ __forceinline__ unsigned cvtpk(float lo, float hi) {
    unsigned r; asm volatile("v_cvt_pk_bf16_f32 %0, %1, %2" : "=v"(r) : "v"(lo), "v"(hi)); return r;
}
__device__ __forceinline__ bf16x8 pack8(f32x4 a, f32x4 b) {
    u32x4 w = {cvtpk(a[0], a[1]), cvtpk(a[2], a[3]), cvtpk(b[0], b[1]), cvtpk(b[2], b[3])};
    return *reinterpret_cast<bf16x8*>(&w);
}
template <class T> __device__ __forceinline__ bf16x8 load8(const T* p) {
    if constexpr (same_t<T, float>::v) { return pack8(*(const f32x4*)p, *(const f32x4*)(p + 4)); }
    else { return *reinterpret_cast<const bf16x8*>(p); }
}
__device__ __forceinline__ void mask_tile(f32x16& p0, f32x16& p1, int dq, unsigned W) {
    const float NEG = -__builtin_inff();
#pragma unroll
    for (int r = 0; r < 16; ++r) {
        const int c = (r & 3) + 8 * (r >> 2);
        if ((unsigned)(dq - c) >= W) p0[r] = NEG;
        if ((unsigned)(dq - c - 32) >= W) p1[r] = NEG;
    }
}
__device__ __forceinline__ void partialSM(f32x16& p0, f32x16& p1, float& m_reg, float& mn, float& alpha) {
    float pmax = p0[0]; for (int r = 1; r < 16; ++r) pmax = fmaxf(pmax, p0[r]); for (int r = 0; r < 16; ++r) pmax = fmaxf(pmax, p1[r]);
    { auto rr = __builtin_amdgcn_permlane32_swap(__float_as_uint(pmax), __float_as_uint(pmax), false, false);
      pmax = fmaxf(__uint_as_float(rr[0]), __uint_as_float(rr[1])); }
    constexpr float C2 = 1.4426950408889634f * SCALE;
    if (__builtin_expect(__all((pmax - m_reg) * SCALE <= THR), 1)) { mn = m_reg; alpha = 1.f; }
    else { mn = fmaxf(m_reg, pmax); alpha = __builtin_amdgcn_exp2f((m_reg - mn) * C2); m_reg = mn; }
    const float mnL = -mn * C2;
    for (int r = 0; r < 16; ++r) p0[r] = fmaf(p0[r], C2, mnL); for (int r = 0; r < 16; ++r) p1[r] = fmaf(p1[r], C2, mnL);
    for (int r = 0; r < 16; ++r) p0[r] = __builtin_amdgcn_exp2f(p0[r]);
}
__device__ __forceinline__ void finishSM(f32x16& p0, f32x16& p1, float alpha, float& l_reg, bf16x8& pa0, bf16x8& pa1, bf16x8& pa2, bf16x8& pa3) {
    for (int r = 0; r < 16; ++r) p1[r] = __builtin_amdgcn_exp2f(p1[r]);
    float ps = 0; for (int r = 0; r < 16; ++r) ps += p0[r]; for (int r = 0; r < 16; ++r) ps += p1[r];
    { auto rr = __builtin_amdgcn_permlane32_swap(__float_as_uint(ps), __float_as_uint(ps), false, false);
      ps = __uint_as_float(rr[0]) + __uint_as_float(rr[1]); }
    l_reg = l_reg * alpha + ps;
#define PK4(P, B_, OUT) do { unsigned a0 = cvtpk(P[B_+0], P[B_+1]), a1 = cvtpk(P[B_+2], P[B_+3]);                          \
        unsigned b0 = cvtpk(P[B_+4], P[B_+5]), b1 = cvtpk(P[B_+6], P[B_+7]);                                             \
        auto r0 = __builtin_amdgcn_permlane32_swap(a0, b0, false, false); auto r1 = __builtin_amdgcn_permlane32_swap(a1, b1, false, false); \
        u32x4 w = {r0[0], r1[0], r0[1], r1[1]}; OUT = *reinterpret_cast<bf16x8*>(&w); } while (0)
    PK4(p0, 0, pa0); PK4(p0, 8, pa1); PK4(p1, 0, pa2); PK4(p1, 8, pa3);
#undef PK4
}
template <int KB, bool SK>
__device__ __forceinline__ void qkt(f32x16& p0, f32x16& p1, const char* K_lds, int r32, int hi, const bf16x8* qr, bool act) {
    if (SK && !act) { const float NEG = -__builtin_inff();
#pragma unroll
        for (int r = 0; r < 16; ++r) { p0[r] = NEG; p1[r] = NEG; } return; }
    p0 = f32x16{}; p1 = f32x16{};
    const char* kb[4];
#pragma unroll
    for (int dd = 0; dd < 4; ++dd) kb[dd] = K_lds + KB * SHM_K + KSWZ(r32, (dd * 16 + hi * 8) * 2);
#pragma unroll
    for (int d0 = 0; d0 < 8; ++d0) { const char* a = kb[d0 & 3] + (d0 >> 2) * 128;
        bf16x8 b0 = *reinterpret_cast<const bf16x8*>(a);
        bf16x8 b1 = *reinterpret_cast<const bf16x8*>(a + 32 * 256);
        p0 = __builtin_amdgcn_mfma_f32_32x32x16_bf16(b0, qr[d0], p0, 0, 0, 0);
        p1 = __builtin_amdgcn_mfma_f32_32x32x16_bf16(b1, qr[d0], p1, 0, 0, 0); }
}
template <int VB, bool SK>
__device__ __forceinline__ void pv_tile(f32x16* o, int vb0, bf16x8 pa0, bf16x8 pa1, bf16x8 pa2, bf16x8 pa3, bool act) {
    if (SK && !act) return;
#define TRRD(dst, off) asm volatile("ds_read_b64_tr_b16 %0, %1 offset:%2" : "=&v"(dst) : "v"(vb0), "i"(off) : "memory")
#define PV_D0(d0) do { s16x4 l0, l1, l2, l3, h0, h1, h2, h3; constexpr int b_ = VB * SHM_V + v_rd_off(d0, 0, 0);     \
        TRRD(l0, b_); TRRD(h0, b_ + 2048); TRRD(l1, b_ + 4096); TRRD(h1, b_ + 6144); TRRD(l2, b_ + 8192); TRRD(h2, b_ + 10240); TRRD(l3, b_ + 12288); TRRD(h3, b_ + 14336); \
        asm volatile("s_waitcnt lgkmcnt(0)" ::: "memory"); SBAR();                 \
        o[d0] = __builtin_amdgcn_mfma_f32_32x32x16_bf16(pa0, (bf16x8){l0[0], l0[1], l0[2], l0[3], h0[0], h0[1], h0[2], h0[3]}, o[d0], 0, 0, 0);   \
        o[d0] = __builtin_amdgcn_mfma_f32_32x32x16_bf16(pa1, (bf16x8){l1[0], l1[1], l1[2], l1[3], h1[0], h1[1], h1[2], h1[3]}, o[d0], 0, 0, 0);   \
        o[d0] = __builtin_amdgcn_mfma_f32_32x32x16_bf16(pa2, (bf16x8){l2[0], l2[1], l2[2], l2[3], h2[0], h2[1], h2[2], h2[3]}, o[d0], 0, 0, 0);   \
        o[d0] = __builtin_amdgcn_mfma_f32_32x32x16_bf16(pa3, (bf16x8){l3[0], l3[1], l3[2], l3[3], h3[0], h3[1], h3[2], h3[3]}, o[d0], 0, 0, 0); } while (0)
    PV_D0(0); PV_D0(1); PV_D0(2); PV_D0(3);
#undef PV_D0
#undef TRRD
}

template <class TIn, class TOut> struct BlockRef { const TIn* Q; const TIn* K; const TIn* V; TOut* O; int P0; };
template <class TIn> struct Seam {
    bf16x8 qr[8];
    bf16x8 st_v0, st_v1, st_k0, st_k1; f32x4 sf0, sf1, sf2, sf3;
    f32x4 tq[16];
};
__device__ __forceinline__ int swa_jlo(int P0, int W) { const int lowk = P0 - W + 1; return lowk > 0 ? lowk / KVBLK : 0; }
#define ROW(p, k0, rr) ((p) + (size_t)((k0) + (rr)) * KVP + sc)
#define VMW() asm volatile("s_waitcnt vmcnt(0)" ::: "memory")
#define VMWN(n) asm volatile("s_waitcnt vmcnt(%0)" :: "i"(n) : "memory")
#define SLOAD_H(Kp, Vp, k0) do { S.st_v0 = load8<TIn>(ROW(Vp, k0, sr)); S.st_v1 = load8<TIn>(ROW(Vp, k0, 32 + sr));              \
                         S.st_k0 = load8<TIn>(ROW(Kp, k0, sr)); S.st_k1 = load8<TIn>(ROW(Kp, k0, 32 + sr)); } while (0)
#define SWRITE_HK(bf) do { *(bf16x8*)(K_lds + (bf) * SHM_K + kws) = S.st_k0; *(bf16x8*)(K_lds + (bf) * SHM_K + kws + 32 * 256) = S.st_k1; } while (0)
#define SWRITE_HV(bf) do { *(bf16x8*)(V_lds + (bf) * SHM_V + vst0) = S.st_v0; *(bf16x8*)(V_lds + (bf) * SHM_V + vst1) = S.st_v1; } while (0)
#define SWRITE_H(bf) do { SWRITE_HV(bf); SWRITE_HK(bf); } while (0)
#define SLOAD_F(p, k0) do { S.sf0 = *(const f32x4*)ROW(p, k0, sr); S.sf1 = *(const f32x4*)(ROW(p, k0, sr) + 4);                \
                            S.sf2 = *(const f32x4*)ROW(p, k0, 32 + sr); S.sf3 = *(const f32x4*)(ROW(p, k0, 32 + sr) + 4); } while (0)
#define SWRITE_KF(bf) do { *(bf16x8*)(K_lds + (bf) * SHM_K + kws) = pack8(S.sf0, S.sf1); *(bf16x8*)(K_lds + (bf) * SHM_K + kws + 32 * 256) = pack8(S.sf2, S.sf3); } while (0)
#define SWRITE_VF(bf) do { *(bf16x8*)(V_lds + (bf) * SHM_V + vst0) = pack8(S.sf0, S.sf1); *(bf16x8*)(V_lds + (bf) * SHM_V + vst1) = pack8(S.sf2, S.sf3); } while (0)
template <class TIn, class TOut, int QP, int KVP, int OP>
__device__ __forceinline__ void causal_swa_prime(const BlockRef<TIn, TOut>& cur, int W, char* lds, Seam<TIn>& S) {
    constexpr bool F32 = same_t<TIn, float>::v;
    int tid_ = threadIdx.x; asm volatile("" : "+v"(tid_));
    const int tid = tid_, wid = __builtin_amdgcn_readfirstlane(tid >> 6), lane = tid & 63, r32 = lane & 31, hi = lane >> 5;
    const int sr = tid >> 4, sc = (tid & 15) * 8, kws = KSWZ(sr, sc * 2); char* K_lds = lds + 2 * SHM_V;
    const int kb0 = swa_jlo(cur.P0, W) * KVBLK;
    for (int d0 = 0; d0 < 8; ++d0) S.qr[d0] = load8<TIn>(cur.Q + (size_t)(wid * QBLK + r32) * QP + d0 * 16 + hi * 8);
    if constexpr (F32) { SLOAD_F((const float*)cur.K, kb0); VMW(); SWRITE_KF(0); SBAR(); SLOAD_F((const float*)cur.V, kb0); }
    else { SLOAD_H(cur.K, cur.V, kb0); VMW(); SWRITE_HK(0); }
    __syncthreads();
}
template <class TIn, class TOut, int QP, int KVP, int OP>
__device__ __forceinline__ void causal_swa_block(const BlockRef<TIn, TOut>& cur, const BlockRef<TIn, TOut>& nxt, int skv, int W, char* lds, Seam<TIn>& S) {
    constexpr bool F32 = same_t<TIn, float>::v;
    int tid_ = threadIdx.x; asm volatile("" : "+v"(tid_));
    const int tid = tid_, wid = __builtin_amdgcn_readfirstlane(tid >> 6), lane = tid & 63, r32 = lane & 31, hi = lane >> 5;
    const int j_lo = swa_jlo(cur.P0, W);
    int j_hi = (cur.P0 + QB - 1) / KVBLK + 1; if (j_hi > skv / KVBLK) j_hi = skv / KVBLK;
    const int NT = j_hi - j_lo;
    const int kbn = swa_jlo(nxt.P0, W) * KVBLK;
    const int qlo = cur.P0 + wid * QBLK, qm = qlo + r32 - 4 * hi;
    char* V_lds = lds; char* K_lds = lds + 2 * SHM_V;
    float* ws = (float*)(lds + 2 * SHM_V + 2 * SHM_K) + wid * 64; float* li_l = ws, * al_l = ws + 32;
    float m_reg = -1e30f, l_reg = 0; f32x16 o[4] = {};
    const int sr = tid >> 4, sc = (tid & 15) * 8, vst0 = v_st(sr, sc), vst1 = v_st(32 + sr, sc), kws = KSWZ(sr, sc * 2);
    const int vb0 = (int)(uintptr_t)V_lds + v_rd_base(lane);
    const TIn* Kh = cur.K; const TIn* Vh = cur.V;
#define RESC(a) do { if (__any((a) < 1.f)) { if (hi == 0) al_l[r32] = (a); asm volatile("s_waitcnt lgkmcnt(0)" ::: "memory");              \
                     for (int d_ = 0; d_ < 4; ++d_) for (int r = 0; r < 16; ++r) o[d_][r] *= al_l[crow(r, hi)]; } } while (0)
#define KBASE(t) ((j_lo + (t)) * KVBLK)
#define ACT(t) (KBASE(t) <= qlo + QBLK - 1 && KBASE(t) + KVBLK - 1 >= qlo - W + 1)
#define MASKT(P0_, P1_, t) do { const int kb_ = KBASE(t); if ((!SK || ACT(t)) && (kb_ + KVBLK - 1 > qlo || kb_ <= qlo + QBLK - 1 - W)) mask_tile(P0_, P1_, qm - kb_, (unsigned)W); } while (0)
    constexpr int NQL = F32 ? 16 : 8;
    constexpr bool SK = WSKIP && !F32;
#define SEAM_K0() do { VMWN(NQL); if constexpr (F32) { SWRITE_KF(0); SBAR(); SLOAD_F((const float*)nxt.V, kbn); } else { SWRITE_HK(0); } SBAR(); } while (0)
    f32x16 pA0, pA1, pB0, pB1; float mnA, mnB, alA, alB; bf16x8 pa0, pa1, pa2, pa3;
    if constexpr (F32) { VMW(); SWRITE_VF(0); SBAR(); } else { SWRITE_HV(0); SBAR(); }
    if (NT > 1) { if constexpr (F32) SLOAD_F((const float*)Kh, KBASE(1)); else SLOAD_H(Kh, Vh, KBASE(1)); }
    SBAR(); qkt<0, SK>(pA0, pA1, K_lds, r32, hi, S.qr, ACT(0));
    if constexpr (F32) { if (NT > 1) { VMW(); SWRITE_KF(1); SBAR(); SLOAD_F((const float*)Vh, KBASE(1)); } }
    MASKT(pA0, pA1, 0); partialSM(pA0, pA1, m_reg, mnA, alA);
    if (NT > 1) { VMW(); if constexpr (F32) { SWRITE_VF(1); SBAR(); if (NT > 2) SLOAD_F((const float*)Kh, KBASE(2)); } else SWRITE_H(1); }
    __syncthreads();
#define HALF_STEP(PX0, PX1, mnX, alX, PY0, PY1, alY, t, KB, VB, SB) do {                                                      \
        SBAR(); qkt<KB, SK>(PX0, PX1, K_lds, r32, hi, S.qr, ACT(t));                                             \
        finishSM(PY0, PY1, alY, l_reg, pa0, pa1, pa2, pa3); SBAR();                                                           \
        if ((t) + 1 < NT) { if constexpr (F32) { VMW(); SWRITE_KF(SB); SBAR(); SLOAD_F((const float*)Vh, KBASE((t) + 1)); }  \
                            else { SLOAD_H(Kh, Vh, KBASE((t) + 1)); } SBAR(); }                                               \
        pv_tile<VB, SK>(o, vb0, pa0, pa1, pa2, pa3, ACT((t) - 1)); MASKT(PX0, PX1, (t)); partialSM(PX0, PX1, m_reg, mnX, alX);                                        \
        __syncthreads();                                                                                                      \
        if ((t) + 1 < NT) { VMW(); if constexpr (F32) { SWRITE_VF(SB); SBAR(); if ((t) + 2 < NT) SLOAD_F((const float*)Kh, KBASE((t) + 2)); } \
                            else { SWRITE_H(SB); } }                                                                          \
        RESC(alX); __syncthreads(); } while (0)
    for (int t = 1; t + 1 < NT; t += 2) {
        HALF_STEP(pB0, pB1, mnB, alB, pA0, pA1, alA, t, 1, 0, 0);
        HALF_STEP(pA0, pA1, mnA, alA, pB0, pB1, alB, t + 1, 0, 1, 1);
    }
    const bool even = (NT & 1) == 0;
    if (even) { SBAR(); qkt<1, SK>(pB0, pB1, K_lds, r32, hi, S.qr, ACT(NT - 1)); SBAR(); }
#define QROW(e) (nxt.Q + (size_t)(wid * QBLK + r32) * QP + ((e) >> 1) * 16 + hi * 8 + ((e) & 1) * 4)
    if constexpr (F32) { SLOAD_F((const float*)nxt.K, kbn); SBAR();
#pragma unroll
        for (int e = 0; e < 8; ++e) S.tq[e] = *(const f32x4*)QROW(e); }
    else { SLOAD_H(nxt.K, nxt.V, kbn); SBAR();
#pragma unroll
        for (int d0 = 0; d0 < 8; ++d0) S.qr[d0] = load8<TIn>(nxt.Q + (size_t)(wid * QBLK + r32) * QP + d0 * 16 + hi * 8); }
    SBAR();
    finishSM(pA0, pA1, alA, l_reg, pa0, pa1, pa2, pa3); SBAR();
    if constexpr (F32) {
#pragma unroll
        for (int e = 8; e < 16; ++e) S.tq[e] = *(const f32x4*)QROW(e); SBAR(); }
#undef QROW
    pv_tile<0, SK>(o, vb0, pa0, pa1, pa2, pa3, ACT(even ? NT - 2 : NT - 1));
    if (even) { MASKT(pB0, pB1, NT - 1); partialSM(pB0, pB1, m_reg, mnB, alB); __syncthreads(); RESC(alB);
        finishSM(pB0, pB1, alB, l_reg, pa0, pa1, pa2, pa3); SBAR(); pv_tile<1, SK>(o, vb0, pa0, pa1, pa2, pa3, ACT(NT - 1)); }
    SBAR(); SEAM_K0();
    if (hi == 0) li_l[r32] = l_reg; asm volatile("s_waitcnt lgkmcnt(0)" ::: "memory");
    float rli[16];
#pragma unroll
    for (int r = 0; r < 16; ++r) rli[r] = __builtin_amdgcn_rcpf(li_l[crow(r, hi)]);
    TOut* Ow = cur.O + (size_t)(wid * QBLK) * OP;
#pragma unroll
    for (int r = 0; r < 16; ++r) { const int orow = crow(r, hi);
#pragma unroll
        for (int d0 = 0; d0 < 4; ++d0) { const float v = o[d0][r] * rli[r];
            if constexpr (same_t<TOut, float>::v) { Ow[(size_t)orow * OP + d0 * 32 + r32] = v; }
            else { const float vn = __shfl_xor(v, 1);
                   if ((r32 & 1) == 0) *(unsigned*)(Ow + (size_t)orow * OP + d0 * 32 + r32) = cvtpk(v, vn); } } }
    if constexpr (F32) {
#pragma unroll
        for (int d0 = 0; d0 < 8; ++d0) S.qr[d0] = pack8(S.tq[2 * d0], S.tq[2 * d0 + 1]); }
    __syncthreads();
#undef RESC
#undef KBASE
#undef ACT
#undef MASKT
#undef SEAM_K0
#undef HALF_STEP
}
#undef ROW
#undef VMW
#undef VMWN
#undef SLOAD_H
#undef SWRITE_HK
#undef SWRITE_HV
#undef SWRITE_H
#undef SLOAD_F
#undef SWRITE_KF
#undef SWRITE_VF
#undef SBAR
}

#define LAS __attribute__((address_space(3)))
typedef unsigned short bf16;
typedef unsigned v4u __attribute__((ext_vector_type(4)));
typedef unsigned v2u __attribute__((ext_vector_type(2)));
typedef float f32x4 __attribute__((ext_vector_type(4)));
constexpr int NWAVES = 8;
constexpr int BATCH = 4, SEQ = 2048, DM = 2048, M = BATCH * SEQ, DFF = 5504, NMIX = 16384, MEML = 256, MM = BATCH * MEML, XW = 512;
constexpr float NORM_EPS = 1e-6f, SUBLN_EPS = 1e-5f, LAM_INIT = 0.2f;
constexpr size_t MiB = 1u << 20;
constexpr size_t WS_WMIX = 1 * MiB, WS_WA = 65 * MiB, WS_WC = 73 * MiB, WS_WMO = 81 * MiB, WS_WXQ = 89 * MiB, WS_WXKV = 91 * MiB, WS_WXO = 95 * MiB;
constexpr size_t WS_WGU = 97 * MiB, WS_WD = 140 * MiB;
constexpr size_t WS_H = 162 * MiB, WS_MH = 194 * MiB, WS_XKV = 198 * MiB, WS_XQ = 200 * MiB, WS_XO = 208 * MiB;
constexpr size_t WS_Q = 216 * MiB, WS_K = 248 * MiB, WS_V = 280 * MiB, WS_BG = 312 * MiB, WS_CU = 344 * MiB, WS_GA = 376 * MiB, WS_GC = 408 * MiB, WS_OA = 440 * MiB, WS_OB = 472 * MiB;
constexpr size_t WS_YA = WS_Q, WS_YC = WS_K, WS_T = WS_V, WS_MRG = WS_CU, WS_ACT = WS_Q;
constexpr size_t WS_XB = WS_H, WS_SS = 504 * MiB;
constexpr size_t WS_END = 505 * MiB;
constexpr int LDS_BYTES = 147456;

__device__ __forceinline__ unsigned f2bf(float f) { unsigned u = __builtin_bit_cast(unsigned, f); return (u + 0x7fffu + ((u >> 16) & 1u)) >> 16; }
__device__ __forceinline__ unsigned pk2(float lo, float hi) { return f2bf(lo) | (f2bf(hi) << 16); }
__device__ __forceinline__ float wave_sum(float v) {
#pragma unroll
    for (int o = 1; o < 64; o <<= 1) v += __shfl_xor(v, o);
    return v;
}
template <int MODE> __device__ __forceinline__ int drow_map(int n0, int roff) {
    if (MODE == 0) return n0 + roff;
    if (MODE == 1) return (n0 >> 7) * 256 + roff + (n0 & 127);
    if (n0 < 8192 || n0 >= 12288) return n0;
    const int which = n0 >= 10240, j = n0 - (which ? 10240 : 8192);
    return 8192 + (j >> 7) * 256 + which * 128 + (j & 127);
}
__device__ __forceinline__ void transpose_item(const float* W, int K, int N, bf16* WT, int k0, int n0, int drow0, const float* g, LAS float* scr, int lane) {
#pragma unroll 8
    for (int i = 0; i < 32; ++i) { const int kk = 2 * i + (lane >> 5); scr[kk * 33 + (lane & 31)] = __builtin_nontemporal_load(W + (size_t)(k0 + kk) * N + n0 + (lane & 31)); }
    const int c = lane & 7;
    f32x4 g0 = {1.f, 1.f, 1.f, 1.f}, g1 = g0;
    if (g) { g0 = *(const f32x4*)(g + k0 + 8 * c); g1 = *(const f32x4*)(g + k0 + 8 * c + 4); }
    asm volatile("s_waitcnt lgkmcnt(0)" ::: "memory");
#pragma unroll
    for (int j = 0; j < 4; ++j) { const int n = (lane >> 3) + 8 * j; const LAS float* sp = scr + (8 * c) * 33 + n;
        v4u o; o.x = pk2(sp[0 * 33] * g0.x, sp[1 * 33] * g0.y); o.y = pk2(sp[2 * 33] * g0.z, sp[3 * 33] * g0.w); o.z = pk2(sp[4 * 33] * g1.x, sp[5 * 33] * g1.y); o.w = pk2(sp[6 * 33] * g1.z, sp[7 * 33] * g1.w);
        *(v4u*)(WT + pg8::blk(drow0 + n, k0 + 8 * c, K)) = o; }
    asm volatile("s_waitcnt lgkmcnt(0)" ::: "memory");
}
template <int MODE> __device__ __forceinline__ void transpose_matrix(const float* W, int K, int N, bf16* WT, int roff, const float* g, LAS float* scr, int gw, int ngw, int lane, int it0 = 0, int it1 = 0x7fffffff) {
    const int nblk = N / 32, nitems = min((K / 64) * nblk, it1);
    for (int it = it0 + gw; it < nitems; it += ngw) { const int kb = it / nblk, nb = it - kb * nblk; transpose_item(W, K, N, WT, 64 * kb, 32 * nb, drow_map<MODE>(32 * nb, roff), g, scr, lane); }
}
__device__ __forceinline__ void rms_row_bf16(const float* xrow, const float* g, bf16* obase, int row, int lane) {
    const f32x4* xr = (const f32x4*)xrow + lane; const f32x4* gr = (const f32x4*)g + lane;
    f32x4 v[8]; float s = 0.f;
#pragma unroll
    for (int j = 0; j < 8; ++j) { v[j] = __builtin_nontemporal_load(xr + 64 * j); s += (v[j].x * v[j].x + v[j].y * v[j].y) + (v[j].z * v[j].z + v[j].w * v[j].w); }
    const float r = 1.0f / sqrtf(wave_sum(s) * (1.f / DM) + NORM_EPS);
#pragma unroll
    for (int j = 0; j < 8; ++j) { const f32x4 gg = gr[64 * j]; const f32x4 o = v[j] * r * gg; v2u w; w.x = pk2(o.x, o.y); w.y = pk2(o.z, o.w); *(v2u*)(obase + pg8::blk(row, 4 * lane + 256 * j, DM)) = w; }
}
__device__ __forceinline__ void rms_row_f32(const float* xrow, const float* g, float* orow, int lane) {
    const f32x4* xr = (const f32x4*)xrow + lane; const f32x4* gr = (const f32x4*)g + lane;
    f32x4 v[8]; float s = 0.f;
#pragma unroll
    for (int j = 0; j < 8; ++j) { v[j] = xr[64 * j]; s += (v[j].x * v[j].x + v[j].y * v[j].y) + (v[j].z * v[j].z + v[j].w * v[j].w); }
    const float r = 1.0f / sqrtf(wave_sum(s) * (1.f / DM) + NORM_EPS);
    f32x4* o = (f32x4*)orow + lane;
#pragma unroll
    for (int j = 0; j < 8; ++j) o[64 * j] = v[j] * r * gr[64 * j];
}

constexpr int CW_BAR = 4096;
constexpr size_t CTL_ZERO_BYTES = 65536;
constexpr int XBST_OFF = 139264 - 512;
constexpr int TAB_OFF = 139264;
__device__ __forceinline__ unsigned char* ldp(LAS unsigned char* ldsl, int i) {
    const unsigned long long v = ((LAS unsigned long long*)(ldsl + TAB_OFF))[i];
    unsigned lo = __builtin_amdgcn_readfirstlane((unsigned)v), hi = __builtin_amdgcn_readfirstlane((unsigned)(v >> 32));
    asm volatile("" : "+s"(lo), "+s"(hi));
    return (unsigned char*)(__attribute__((address_space(1))) unsigned char*)(((unsigned long long)hi << 32) | lo);
}
#define XB_TMO      128
#define XB_XCNT(j)  (256  + 64 * (j))
#define XB_XSUB(j)  (1280 + 64 * (j))
#define XB_XGEN(j)  (2304 + 64 * (j))
#define XB_TOP      3328
#define XB_TOPGEN   3392
#define XCD_BAR_WORDS 3456
#define XB_SPIN_CAP (1u << 18)

__device__ __forceinline__ unsigned xb_ld(unsigned* p)              { return __hip_atomic_load(p, __ATOMIC_RELAXED, __HIP_MEMORY_SCOPE_AGENT); }
__device__ __forceinline__ unsigned xb_add(unsigned* p, unsigned v) { return __hip_atomic_fetch_add(p, v, __ATOMIC_RELAXED, __HIP_MEMORY_SCOPE_AGENT); }
__device__ __forceinline__ unsigned xb_xcc_id() { return (unsigned)__builtin_amdgcn_s_getreg((3 << 11) | 20) & 0xFu; }
#define XB_SPIN(cond, bar) do { unsigned _sp = 0; while (cond) { __builtin_amdgcn_s_sleep(1); \
    if ((++_sp & 255u) == 0u) { if (xb_ld(&(bar)[XB_TMO])) break; if (_sp > XB_SPIN_CAP) { atomicAdd(&(bar)[XB_TMO], 1u); break; } } } } while (0)

struct XcdBarrier {
    unsigned* bar; unsigned x;
    volatile LAS unsigned* st;
};

__device__ __forceinline__ XcdBarrier xcd_barrier_post(unsigned* bar, volatile LAS unsigned* st) {
    XcdBarrier b; b.bar = bar; b.x = xb_xcc_id(); b.st = st;
    if (threadIdx.x == 0) (void)xb_add(&bar[XB_XCNT(b.x)], 1u);
    return b;
}
__device__ __forceinline__ void xcd_barrier_complete(unsigned* bar, unsigned x, unsigned& nloc, unsigned& nx) {
    const unsigned G = gridDim.x * gridDim.y * gridDim.z;
    unsigned sum, cnt, mine, sp = 0u;
    for (;;) {
        sum = 0u; cnt = 0u; mine = 0u;
#pragma unroll
        for (unsigned j = 0; j < 16; ++j) { const unsigned c = xb_ld(&bar[XB_XCNT(j)]); sum += c; cnt += (c > 0u) ? 1u : 0u; mine = (j == x) ? c : mine; }
        if (sum == G) break;
        __builtin_amdgcn_s_sleep(1);
        if ((++sp & 255u) == 0u) { if (xb_ld(&bar[XB_TMO])) break; if (sp > XB_SPIN_CAP) { atomicAdd(&bar[XB_TMO], 1u); break; } }
    }
    nloc = mine > 0u ? mine : 1u; nx = cnt > 0u ? cnt : 1u;
}

__device__ __forceinline__ void xcd_barrier(const XcdBarrier& b) {
    asm volatile("s_waitcnt vmcnt(0)" ::: "memory");
    __syncthreads();
    if (threadIdx.x == 0) {
        unsigned* bar = b.bar;
        __builtin_amdgcn_s_waitcnt(0);
        unsigned nloc = b.st[0], nx = b.st[1];
        if (nloc == 0u) { xcd_barrier_complete(bar, b.x, nloc, nx); b.st[0] = nloc; b.st[1] = nx; }
        const unsigned old = xb_add(&bar[XB_XSUB(b.x)], 1u);
        const unsigned gen = old / nloc;
        if (old + 1u == (gen + 1u) * nloc) {
            __builtin_amdgcn_fence(__ATOMIC_RELEASE, "agent");
            asm volatile("s_waitcnt vmcnt(0)" ::: "memory");
            const unsigned og = xb_add(&bar[XB_TOP], 1u);
            const unsigned tg = og / nx;
            if (og + 1u == (tg + 1u) * nx) xb_add(&bar[XB_TOPGEN], 1u);
            else XB_SPIN(xb_ld(&bar[XB_TOPGEN]) == tg, bar);
            __builtin_amdgcn_fence(__ATOMIC_ACQUIRE, "agent");
            xb_add(&bar[XB_XGEN(b.x)], 1u);
            asm volatile("s_waitcnt vmcnt(0)" ::: "memory");
        } else {
            XB_SPIN(xb_ld(&bar[XB_XGEN(b.x)]) == gen, bar);
            __builtin_amdgcn_fence(__ATOMIC_ACQUIRE, "agent");
            asm volatile("s_waitcnt vmcnt(0)" ::: "memory");
        }
    }
    __syncthreads();
}

struct EpiFinal {
    static constexpr bool PERM = true, AFTER_DRAIN = true;
    const bf16* base; float* out; float* SSp; const float* g; unsigned* bar; volatile LAS unsigned* st; float alpha;
    __device__ __forceinline__ void fused(pg8::f32x4 (&acc)[2][2][4][2], const pg8::Unit& u, int wr, int wc, int fr, int fq, LAS unsigned char*, int, int) const {
        using pg8::f32x4; constexpr int BM = pg8::BM, HALF = pg8::HALF;
        const int row0 = u.pm * BM + wr * 64 + fr, col0 = u.pn * BM + wc * 32 + 8 * fq;
#pragma unroll
        for (int ai = 0; ai < 2; ++ai) { f32x4 b[4][2][2];
#pragma unroll
            for (int m = 0; m < 4; ++m) { const size_t off = (size_t)(row0 + ai * HALF + m * 16) * 2048 + col0;
#pragma unroll
                for (int bj = 0; bj < 2; ++bj) { const pg8::u32x4 w = __builtin_nontemporal_load((const pg8::u32x4*)(base + pg8::blk(row0 + ai * HALF + m * 16, col0 + bj * HALF, 2048))); b[m][bj][0] = pg8::lo4(w); b[m][bj][1] = pg8::hi4(w); } }
#pragma unroll
            for (int m = 0; m < 4; ++m) { const int row = row0 + ai * HALF + m * 16; float ssq = 0.f;
#pragma unroll
                for (int bj = 0; bj < 2; ++bj) { const f32x4 o0 = b[m][bj][0] + alpha * acc[ai][bj][m][0], o1 = b[m][bj][1] + alpha * acc[ai][bj][m][1];
                    acc[ai][bj][m][0] = o0; acc[ai][bj][m][1] = o1;
                    ssq += ((o0[0] * o0[0] + o0[1] * o0[1]) + (o0[2] * o0[2] + o0[3] * o0[3])) + ((o1[0] * o1[0] + o1[1] * o1[1]) + (o1[2] * o1[2] + o1[3] * o1[3])); }
                ssq += __shfl_xor(ssq, 16); ssq += __shfl_xor(ssq, 32);
                if (fq == 0) SSp[(size_t)row * 32 + u.pn * 4 + wc] = ssq; } }
        { XcdBarrier xb_; xb_.bar = bar; xb_.x = xb_xcc_id(); xb_.st = st; xcd_barrier(xb_); }
        float rsa[2][4];
#pragma unroll
        for (int ai = 0; ai < 2; ++ai)
#pragma unroll
            for (int m = 0; m < 4; ++m) rsa[ai][m] = pg8::row_rscale(SSp, row0 + ai * HALF + m * 16, fq);
        f32x4 gg[2][2];
#pragma unroll
        for (int bj = 0; bj < 2; ++bj) { gg[bj][0] = *(const f32x4*)(g + col0 + bj * HALF); gg[bj][1] = *(const f32x4*)(g + col0 + bj * HALF + 4); }
#pragma unroll
        for (int ai = 0; ai < 2; ++ai)
#pragma unroll
            for (int m = 0; m < 4; ++m) { const size_t off = (size_t)(row0 + ai * HALF + m * 16) * 2048 + col0;
#pragma unroll
                for (int bj = 0; bj < 2; ++bj) { *(f32x4*)(out + off + bj * HALF) = acc[ai][bj][m][0] * rsa[ai][m] * gg[bj][0]; *(f32x4*)(out + off + bj * HALF + 4) = acc[ai][bj][m][1] * rsa[ai][m] * gg[bj][1]; } }
    }
};

constexpr int MIX_SPLIT = 4096;
struct Args { const float* in[28]; float* out; unsigned char* ws; };
enum { I_X = 0, I_MEM, I_F1N, I_F1G, I_F1U, I_F1D, I_MIXN, I_WMIX, I_BG, I_LQ1, I_LK1, I_LQ2, I_LK2, I_SUBLN, I_WA, I_CONVW, I_WC, I_WMO, I_XN, I_MEMN, I_WXQ, I_WXKV, I_WXO, I_F2N, I_F2G, I_F2U, I_F2D, I_FINN };

typedef ab::BlockRef<ab::bf16, ab::bf16> BRef;
__device__ __forceinline__ BRef self_ref(int L, int pass, const bf16* Q, const bf16* K, const bf16* V, bf16* OA, bf16* OB) {
    const int x = L & 3, rest = L >> 2, half = rest & 1, c = (rest >> 1) & 1, h = (rest >> 2) & 7, b = rest >> 5;
    const int qb = pass ? 7 - x : x;
    BRef r; const size_t rb = (size_t)b * SEQ * DM;
    r.Q = (const ab::bf16*)(Q + rb + (size_t)qb * 256 * DM + (h * 2 + c) * 128);
    r.K = (const ab::bf16*)(K + rb + (h * 2 + c) * 128);
    r.V = (const ab::bf16*)(V + rb + h * 256 + half * 128);
    r.O = (ab::bf16*)((c ? OB : OA) + rb + (size_t)qb * 256 * DM + h * 256 + half * 128);
    r.P0 = qb * 256; return r;
}
__device__ __forceinline__ BRef cross_ref(int L, const bf16* XQ, const bf16* XKV, bf16* XO) {
    const int qb = L & 7, hd = (L >> 3) & 3, b = L >> 5;
    BRef r;
    r.Q = (const ab::bf16*)(XQ + ((size_t)b * SEQ + qb * 256) * XW + hd * 128);
    r.K = (const ab::bf16*)(XKV + (size_t)b * MEML * 1024 + hd * 128);
    r.V = (const ab::bf16*)(XKV + (size_t)b * MEML * 1024 + 512 + hd * 128);
    r.O = (ab::bf16*)(XO + ((size_t)b * SEQ + qb * 256) * XW + hd * 128);
    r.P0 = 256; return r;
}

#define P_(name, off) ((bf16*)(ldp(ldsl, 29) + (off)))
#define WMIX P_(0, WS_WMIX)
#define WA P_(0, WS_WA)
#define WC P_(0, WS_WC)
#define WMO P_(0, WS_WMO)
#define WXQ P_(0, WS_WXQ)
#define WXKV P_(0, WS_WXKV)
#define WXO P_(0, WS_WXO)
#define WGU P_(0, WS_WGU)
#define WD P_(0, WS_WD)
#define H P_(0, WS_H)
#define MH P_(0, WS_MH)
#define XKV P_(0, WS_XKV)
#define XQ P_(0, WS_XQ)
#define XO P_(0, WS_XO)
#define Qb P_(0, WS_Q)
#define Kb P_(0, WS_K)
#define Vb P_(0, WS_V)
#define BG P_(0, WS_BG)
#define CU P_(0, WS_CU)
#define GA P_(0, WS_GA)
#define GC P_(0, WS_GC)
#define OA P_(0, WS_OA)
#define OB P_(0, WS_OB)
#define YA P_(0, WS_YA)
#define YC P_(0, WS_YC)
#define MRG P_(0, WS_MRG)
#define ACT P_(0, WS_ACT)
#define T P_(0, WS_T)
#define XB P_(0, WS_XB)
#define SS ((float*)(ldp(ldsl, 29) + WS_SS))
#define X ((float*)ldp(ldsl, 28))
#define IN(i) ((const float*)ldp(ldsl, (i)))
__global__ void __launch_bounds__(NWAVES * 64, 2) mk_fwd(Args a) {
    extern __shared__ __attribute__((aligned(16))) unsigned char lds[];
    LAS unsigned char* ldsl = (LAS unsigned char*)lds;
    if (threadIdx.x < 28) ((LAS unsigned long long*)(ldsl + TAB_OFF))[threadIdx.x] = (unsigned long long)a.in[threadIdx.x];
    if (threadIdx.x == 28) ((LAS unsigned long long*)(ldsl + TAB_OFF))[28] = (unsigned long long)a.out;
    if (threadIdx.x == 29) ((LAS unsigned long long*)(ldsl + TAB_OFF))[29] = (unsigned long long)a.ws;
    if (threadIdx.x == 30) { ((volatile LAS unsigned*)(ldsl + XBST_OFF))[0] = 0u; ((volatile LAS unsigned*)(ldsl + XBST_OFF))[1] = 0u; }
    __syncthreads();
    cg::this_grid().sync();
    XcdBarrier xbar = xcd_barrier_post((unsigned*)a.ws + CW_BAR, (volatile LAS unsigned*)(ldsl + XBST_OFF));
#define GRID_SYNC() do { XcdBarrier xb_; xb_.bar = (unsigned*)ldp(ldsl, 29) + CW_BAR; xb_.x = xb_xcc_id(); xb_.st = (volatile LAS unsigned*)(ldsl + XBST_OFF); xcd_barrier(xb_); } while (0)
    (void)xbar;
    const int G = gridDim.x, bx = blockIdx.x, NGW = G * NWAVES;
#define TL() int tid = threadIdx.x; asm volatile("" : "+v"(tid)); const int lane = tid & 63, wave = __builtin_amdgcn_readfirstlane(tid >> 6), gw = bx * NWAVES + wave; LAS float* scr = (LAS float*)(ldsl + wave * 16640); (void)lane; (void)gw; (void)scr;

    { TL();
    transpose_matrix<1>(IN(I_F1G), DM, DFF, WGU, 0, nullptr, scr, gw, NGW, lane);
    transpose_matrix<1>(IN(I_F1U), DM, DFF, WGU, 128, nullptr, scr, gw, NGW, lane);
    transpose_matrix<0>(IN(I_F1D), DFF, DM, WD, 0, nullptr, scr, gw, NGW, lane);
    transpose_matrix<2>(IN(I_WMIX), DM, NMIX, WMIX, 0, IN(I_MIXN), scr, gw, NGW, lane, 0, MIX_SPLIT);
    transpose_matrix<0>(IN(I_WA), DM, DM, WA, 0, nullptr, scr, gw, NGW, lane);
    transpose_matrix<0>(IN(I_WC), DM, DM, WC, 0, nullptr, scr, gw, NGW, lane);
    transpose_matrix<0>(IN(I_WMO), DM, DM, WMO, 0, nullptr, scr, gw, NGW, lane);
    transpose_matrix<0>(IN(I_WXQ), DM, XW, WXQ, 0, IN(I_XN), scr, gw, NGW, lane);
    transpose_matrix<0>(IN(I_WXKV), DM, 2 * XW, WXKV, 0, nullptr, scr, gw, NGW, lane);
    transpose_matrix<0>(IN(I_WXO), XW, DM, WXO, 0, nullptr, scr, gw, NGW, lane);
    { const float* xi = IN(I_X); const float* gi = IN(I_F1N); bf16* ho = H; for (int m = gw; m < M; m += NGW) rms_row_bf16(xi + (size_t)m * DM, gi, ho, m, lane); }
    { const float* xi = IN(I_MEM); const float* gi = IN(I_MEMN); bf16* ho = MH; for (int m = gw; m < MM; m += NGW) rms_row_bf16(xi + (size_t)m * DM, gi, ho, m, lane); }
    }
    GRID_SYNC();

    { pg8::Gemm g{H, WGU, M, 2 * DFF, DM, 1, 1}; pg8::StaticOrder S; S.init(M, 2 * DFF, G, bx); pg8::EpiSwiglu E{ACT, DFF, nullptr};
      pg8::gemm_phase<pg8::EpiSwiglu, pg8::StaticOrder, true, true>(ldsl, g, S, E); }
    { pg8::Gemm g{MH, WXKV, MM, 2 * XW, DM, 1, 1}; pg8::StaticOrder S; S.init(MM, 2 * XW, G, G - 1 - bx); pg8::EpiBf16<0> E{XKV, 2 * XW, nullptr, 0, 0, 1.f};
      pg8::gemm_phase<pg8::EpiBf16<0>, pg8::StaticOrder, true, true>(ldsl, g, S, E); }
    if (G == 256 ? (bx >= 96 && bx < 240) : (bx == 0)) { TL(); const int nb_ = (G == 256) ? 144 : 1, b0_ = (G == 256) ? 96 : 0;
      transpose_matrix<2>(IN(I_WMIX), DM, NMIX, WMIX, 0, IN(I_MIXN), scr, (bx - b0_) * NWAVES + wave, nb_ * NWAVES, lane, MIX_SPLIT, 0x7fffffff); }
    GRID_SYNC();

    { pg8::Gemm g{ACT, WD, M, DM, DFF, 1, 1}; pg8::StaticOrder S; S.init(M, DM, G, bx); pg8::EpiResidB<true> E{IN(I_X), XB, SS, 0.5f};
      pg8::gemm_phase<pg8::EpiResidB<true>, pg8::StaticOrder, true, true>(ldsl, g, S, E); }
    GRID_SYNC();

    { pg8::Gemm g{XB, WMIX, M, NMIX, DM, 1, 1}; pg8::StaticOrder S; S.init(M, NMIX, G, bx); pg8::EpiMixIn E{Qb, IN(I_BG), SS};
      pg8::gemm_phase<pg8::EpiMixIn, pg8::StaticOrder, true, true>(ldsl, g, S, E); }
    GRID_SYNC();

    {
        constexpr int TOTAL = BATCH * 8 * 2 * 2 * 4;
#ifndef ATT_REP
#define ATT_REP 1
#endif
        for (int rep = 0; rep < ATT_REP; ++rep) {
        int L = bx;
#ifndef NO_SELF
        if (L < TOTAL) {
            const bf16* q_ = Qb; const bf16* k_ = Kb; const bf16* v_ = Vb; bf16* oa_ = OA; bf16* ob_ = OB;
            int pass = 0; BRef cur = self_ref(L, 0, q_, k_, v_, oa_, ob_);
            ab::Seam<ab::bf16> S;
            ab::causal_swa_prime<ab::bf16, ab::bf16, DM, DM, DM>(cur, 1 << 28, (char*)lds, S);
            for (;;) {
                const bool more_pass = pass == 0, more_item = L + G < TOTAL, last = !more_pass && !more_item;
                int passn = pass + 1, Ln = L;
                if (!more_pass) { passn = 0; Ln = more_item ? L + G : L; }
                const BRef nxt = last ? cur : self_ref(Ln, passn, q_, k_, v_, oa_, ob_);
                ab::causal_swa_block<ab::bf16, ab::bf16, DM, DM, DM>(cur, nxt, SEQ, 1 << 28, (char*)lds, S);
                if (last) break;
                cur = nxt; pass = passn; L = Ln;
            }
        }
#endif
        }
    }
    GRID_SYNC();

    {
        TL();
        {
        const float* cw = IN(I_CONVW); const bf16* cu_ = CU; const bf16* bg_ = BG; bf16* yc_ = YC;
        for (int i = bx * (NWAVES * 64) + tid; i < M * (DM / 8); i += G * NWAVES * 64) {
            const int row = i >> 8, c8 = (i & 255) * 8, s = row & (SEQ - 1); const size_t off = (size_t)row * DM + c8;
            const v4u z4 = {0u, 0u, 0u, 0u};
            const v4u u0 = *(const v4u*)(cu_ + off), u1 = s >= 1 ? *(const v4u*)(cu_ + off - DM) : z4, u2 = s >= 2 ? *(const v4u*)(cu_ + off - 2 * DM) : z4, bb = __builtin_nontemporal_load((const v4u*)(bg_ + off));
            const f32x4 w0a = *(const f32x4*)(cw + c8), w0b = *(const f32x4*)(cw + c8 + 4), w1a = *(const f32x4*)(cw + DM + c8), w1b = *(const f32x4*)(cw + DM + c8 + 4), w2a = *(const f32x4*)(cw + 2 * DM + c8), w2b = *(const f32x4*)(cw + 2 * DM + c8 + 4);
            const f32x4 ra = pg8::lo4(bb) * (w0a * pg8::lo4(u2) + w1a * pg8::lo4(u1) + w2a * pg8::lo4(u0));
            const f32x4 rb = pg8::hi4(bb) * (w0b * pg8::hi4(u2) + w1b * pg8::hi4(u1) + w2b * pg8::hi4(u0));
            v4u o; o.x = pk2(ra.x, ra.y); o.y = pk2(ra.z, ra.w); o.z = pk2(rb.x, rb.y); o.w = pk2(rb.z, rb.w);
            *(v4u*)(yc_ + pg8::blk(row, c8, DM)) = o;
        }
            }
        float d1 = IN(I_LQ1)[lane] * IN(I_LK1)[lane] + IN(I_LQ1)[lane + 64] * IN(I_LK1)[lane + 64];
        float d2 = IN(I_LQ2)[lane] * IN(I_LK2)[lane] + IN(I_LQ2)[lane + 64] * IN(I_LK2)[lane + 64];
        const float lam = expf(wave_sum(d1)) - expf(wave_sum(d2)) + LAM_INIT;
        const f32x4 gs = *((const f32x4*)IN(I_SUBLN) + lane) * (1.0f - LAM_INIT);
        const bf16* oa_ = OA; const bf16* ob_ = OB; bf16* ya_ = YA;
        for (int m = gw; m < M; m += NGW) {
            const v2u* pa = (const v2u*)(oa_ + (size_t)m * DM) + lane; const v2u* pb = (const v2u*)(ob_ + (size_t)m * DM) + lane; v2u* po = (v2u*)(ya_ + (size_t)m * DM) + lane;
#pragma unroll
            for (int j = 0; j < 8; ++j) { const v2u wa = __builtin_nontemporal_load(pa + 64 * j), wb = __builtin_nontemporal_load(pb + 64 * j);
                f32x4 d; d.x = __uint_as_float(wa.x << 16) - lam * __uint_as_float(wb.x << 16); d.y = __uint_as_float(wa.x & 0xffff0000u) - lam * __uint_as_float(wb.x & 0xffff0000u);
                d.z = __uint_as_float(wa.y << 16) - lam * __uint_as_float(wb.y << 16); d.w = __uint_as_float(wa.y & 0xffff0000u) - lam * __uint_as_float(wb.y & 0xffff0000u);
                const float ss = wave_sum((d.x * d.x + d.y * d.y) + (d.z * d.z + d.w * d.w));
                const float r = 1.0f / sqrtf(ss * (1.f / 256.f) + SUBLN_EPS);
                const f32x4 o = d * r * gs; v2u w; w.x = pk2(o.x, o.y); w.y = pk2(o.z, o.w); *(v2u*)(ya_ + pg8::blk(m, 4 * lane + 256 * j, DM)) = w; }
        }
    }
    GRID_SYNC();

    { pg8::Gemm g{YA, WA, M, DM, DM, 1, 1}; pg8::StaticOrder S; S.init(M, DM, G, bx); pg8::EpiGateT E{GA, T};
      pg8::gemm_phase<pg8::EpiGateT, pg8::StaticOrder, true, true>(ldsl, g, S, E); }
    { pg8::Gemm g{YC, WC, M, DM, DM, 1, 1}; pg8::StaticOrder S; S.init(M, DM, G, bx); pg8::EpiGateMrg E{GC, T, MRG};
      pg8::gemm_phase<pg8::EpiGateMrg, pg8::StaticOrder, true, true>(ldsl, g, S, E); }
    GRID_SYNC();

    { pg8::Gemm g{MRG, WMO, M, DM, DM, 1, 1}; pg8::StaticOrder S; S.init(M, DM, G, bx); pg8::EpiResidB<false> E{XB, XB, SS, 1.0f};
      pg8::gemm_phase<pg8::EpiResidB<false>, pg8::StaticOrder, true, true>(ldsl, g, S, E); }
    GRID_SYNC();

    if (bx < 64) { pg8::Gemm g{XB, WXQ, M, XW, DM, 1, 1}; pg8::StaticOrder S; S.init(M, XW, 64, bx); pg8::EpiBf16RS E{XQ, XW, SS};
      pg8::gemm_phase<pg8::EpiBf16RS, pg8::StaticOrder, true, true>(ldsl, g, S, E); }
    else { TL(); const int gw2 = (bx - 64) * NWAVES + wave, ngw2 = (G - 64) * NWAVES;
      transpose_matrix<1>(IN(I_F2G), DM, DFF, WGU, 0, IN(I_F2N), scr, gw2, ngw2, lane);
      transpose_matrix<1>(IN(I_F2U), DM, DFF, WGU, 128, IN(I_F2N), scr, gw2, ngw2, lane);
      transpose_matrix<0>(IN(I_F2D), DFF, DM, WD, 0, nullptr, scr, gw2, ngw2, lane); }
    GRID_SYNC();

    {
        constexpr int TOTAL = BATCH * 4 * 8;
        int L = bx;
#ifndef NO_CROSS
        if (L < TOTAL) {
            const bf16* xq_ = XQ; const bf16* xkv_ = XKV; bf16* xo_ = XO;
            BRef cur = cross_ref(L, xq_, xkv_, xo_);
            ab::Seam<ab::bf16> S;
            ab::causal_swa_prime<ab::bf16, ab::bf16, XW, 2 * XW, XW>(cur, 1 << 28, (char*)lds, S);
            for (;;) {
                const bool last = L + G >= TOTAL; const int Ln = last ? L : L + G;
                const BRef nxt = last ? cur : cross_ref(Ln, xq_, xkv_, xo_);
                ab::causal_swa_block<ab::bf16, ab::bf16, XW, 2 * XW, XW>(cur, nxt, MEML, 1 << 28, (char*)lds, S);
                if (last) break;
                cur = nxt; L = Ln;
            }
        }
#endif
    }
    GRID_SYNC();

    { pg8::Gemm g{XO, WXO, M, DM, XW, 0, 1}; pg8::StaticOrder S; S.init(M, DM, G, bx); pg8::EpiResidB<false> E{XB, XB, SS, 1.0f};
      pg8::gemm_phase<pg8::EpiResidB<false>, pg8::StaticOrder, true, true>(ldsl, g, S, E); }
    GRID_SYNC();

    { pg8::Gemm g{XB, WGU, M, 2 * DFF, DM, 1, 1}; pg8::StaticOrder S; S.init(M, 2 * DFF, G, bx); pg8::EpiSwiglu E{ACT, DFF, SS};
      pg8::gemm_phase<pg8::EpiSwiglu, pg8::StaticOrder, true, true>(ldsl, g, S, E); }
    GRID_SYNC();

    if (G == 256) { pg8::Gemm g{ACT, WD, M, DM, DFF, 1, 1}; pg8::StaticOrder S; S.init(M, DM, G, bx);
      EpiFinal E{XB, X, SS, IN(I_FINN), (unsigned*)ldp(ldsl, 29) + CW_BAR, (volatile LAS unsigned*)(ldsl + XBST_OFF), 0.5f};
      pg8::gemm_phase<EpiFinal, pg8::StaticOrder, true, true>(ldsl, g, S, E); }
    else {
      { pg8::Gemm g{ACT, WD, M, DM, DFF, 1, 1}; pg8::StaticOrder S; S.init(M, DM, G, bx); pg8::EpiResidFromB E{XB, X, 0.5f};
        pg8::gemm_phase<pg8::EpiResidFromB, pg8::StaticOrder, true, true>(ldsl, g, S, E); }
      GRID_SYNC();
      { TL(); float* xi = X; const float* gi = IN(I_FINN); for (int m = gw; m < M; m += NGW) rms_row_f32(xi + (size_t)m * DM, gi, xi + (size_t)m * DM, lane); }
    }
}

extern "C" void kernel_launch(void* const* d_in, const int* in_sizes, int n_in, void* d_out, int out_size, void* d_ws, size_t ws_size, hipStream_t stream) {
    static int grid = 0;
    if (grid == 0) {
        if (n_in != 28 || out_size != M * DM || ws_size < WS_END) { fprintf(stderr, "kernel_launch: unexpected shapes (n_in %d out %d ws %zu)\n", n_in, out_size, ws_size); grid = -1; return; }
        int dev = 0, cus = 0, per_cu = 0;
        (void)hipGetDevice(&dev); (void)hipDeviceGetAttribute(&cus, hipDeviceAttributeMultiprocessorCount, dev);
        if (hipFuncSetAttribute((const void*)mk_fwd, hipFuncAttributeMaxDynamicSharedMemorySize, LDS_BYTES) != hipSuccess) { fprintf(stderr, "kernel_launch: hipFuncSetAttribute failed\n"); grid = -1; return; }
        if (hipOccupancyMaxActiveBlocksPerMultiprocessor(&per_cu, (const void*)mk_fwd, NWAVES * 64, LDS_BYTES) != hipSuccess || per_cu < 1) { fprintf(stderr, "kernel_launch: occupancy query says %d\n", per_cu); (void)hipGetLastError(); grid = -1; return; }
        grid = cus * per_cu;
    }
    if (grid < 0) return;
    if (hipMemsetAsync(d_ws, 0, CTL_ZERO_BYTES, stream) != hipSuccess) { fprintf(stderr, "kernel_launch: memset failed\n"); return; }
    Args a{};
    for (int i = 0; i < 28; ++i) a.in[i] = (const float*)d_in[i];
    a.out = (float*)d_out; a.ws = (unsigned char*)d_ws;
    void* args[] = {&a};
    hipError_t e = hipLaunchCooperativeKernel((const void*)mk_fwd, dim3(grid), dim3(NWAVES * 64), args, LDS_BYTES, stream);
    if (e != hipSuccess) fprintf(stderr, "cooperative launch failed: %s (grid %d)\n", hipGetErrorString(e), grid);
}
```
